# Optimizing an MI355X kernel written in HIP

```python
import math
import jax, jax.numpy as jnp
from jax import lax
import numpy as np

D_MODEL = 1024
BATCH = 8
SEQ = 4096
DEPTH = 1
DEC_BATCH = 2
DEC_SEQ = 16384
PAST_LEN = 128

ATTN_WIDTH = D_MODEL // 2
CONV_WIDTH = D_MODEL - ATTN_WIDTH
HEAD_DIM = 64
N_ATTN_HEADS = ATTN_WIDTH // HEAD_DIM
ATTN_CONFIGS = ((128, 1), (512, 4), (2048, 16))
BLK = 64
CONV_K = 3
D_FF = ((int(math.ceil(8 * D_MODEL / 3)) + 255) // 256) * 256
IN_WIDTH = 3 * ATTN_WIDTH + 3 * CONV_WIDTH
ALPHA = (2.0 * DEPTH) ** 0.25
BETA = (8.0 * DEPTH) ** -0.25
LN_EPS = 1e-5
NEG = -1e30

kernel_name = "hymba_dilated_attn_shortconv_deepnorm_encoder"


def _alibi_slopes():
    return jnp.asarray(np.array([2.0 ** (-8.0 * (h + 1) / N_ATTN_HEADS) for h in range(N_ATTN_HEADS)], dtype=np.float32))


def _layernorm(x, g, b):
    xf = x.astype(jnp.float32)
    mu = jnp.mean(xf, axis=-1, keepdims=True)
    var = jnp.mean(jnp.square(xf - mu), axis=-1, keepdims=True)
    y = (xf - mu) * lax.rsqrt(var + LN_EPS) * g.astype(jnp.float32) + b.astype(jnp.float32)
    return y.astype(x.dtype)


def _rmsnorm(x, g):
    xf = x.astype(jnp.float32)
    y = xf * lax.rsqrt(jnp.mean(jnp.square(xf), axis=-1, keepdims=True) + LN_EPS) * g.astype(jnp.float32)
    return y.astype(x.dtype)


def _dilated_band_attention(q, k, v, window, dilation, slopes):
    B, S, H, Dh = q.shape
    d = dilation
    half = window // (2 * d)
    n = S // d
    nb = -(-n // BLK)
    n_pad = nb * BLK

    def to_sub(t):
        return t.reshape(B, n, d, H, Dh).transpose(0, 2, 1, 3, 4)

    qs = jnp.pad(to_sub(q), ((0, 0), (0, 0), (0, n_pad - n), (0, 0), (0, 0)))
    qs = qs.reshape(B, d, nb, BLK, H, Dh)
    pad_kv = ((0, 0), (0, 0), (BLK, n_pad - n + BLK), (0, 0), (0, 0))
    kp = jnp.pad(to_sub(k), pad_kv)
    vp = jnp.pad(to_sub(v), pad_kv)
    kb = jnp.concatenate([kp[:, :, o:o + n_pad].reshape(B, d, nb, BLK, H, Dh) for o in (0, BLK, 2 * BLK)], axis=3)
    vb = jnp.concatenate([vp[:, :, o:o + n_pad].reshape(B, d, nb, BLK, H, Dh) for o in (0, BLK, 2 * BLK)], axis=3)

    s = jnp.einsum('bdnqhc,bdnkhc->bdnhqk', qs, kb, preferred_element_type=jnp.float32) * (1.0 / math.sqrt(Dh))
    qi = jnp.arange(nb)[:, None] * BLK + jnp.arange(BLK)[None, :]
    kj = jnp.arange(nb)[:, None] * BLK - BLK + jnp.arange(3 * BLK)[None, :]
    rel = jnp.abs(qi[:, :, None] - kj[:, None, :])
    valid = ((kj >= 0) & (kj < n))[:, None, :] & (rel <= half)
    dist = (rel * d).astype(jnp.float32)
    bias = -slopes[None, :, None, None] * dist[:, None]
    s = jnp.where(valid[:, None], s + bias, NEG)
    m = jnp.max(s, axis=-1, keepdims=True)
    p = jnp.exp(s - m)
    den = jnp.sum(p, axis=-1, keepdims=True)
    lse = (m + jnp.log(den))[..., 0]
    o = jnp.einsum('bdnhqk,bdnkhc->bdnqhc', p / den, vb.astype(jnp.float32))
    o = o.reshape(B, d, n_pad, H, Dh)[:, :, :n].transpose(0, 2, 1, 3, 4).reshape(B, S, H, Dh)
    lse = lse.transpose(0, 1, 2, 4, 3).reshape(B, d, n_pad, H)[:, :, :n].transpose(0, 2, 1, 3).reshape(B, S, H)
    return o, lse


def _mixed_dilated_attention(q, k, v):
    slopes = _alibi_slopes()
    outs, lses = [], []
    for window, dilation in ATTN_CONFIGS:
        o, l = _dilated_band_attention(q, k, v, window, dilation, slopes)
        outs.append(o)
        lses.append(l)
    w = jax.nn.softmax(jnp.stack(lses, axis=-1), axis=-1)
    o = sum(outs[i] * w[..., i:i + 1] for i in range(len(ATTN_CONFIGS)))
    return o.astype(q.dtype)


def _short_conv(u, gate_b, gate_c, conv_w):
    h = gate_c * u
    hp = jnp.pad(h, ((0, 0), (1, 1), (0, 0)))
    c = conv_w[0] * hp[:, :-2] + conv_w[1] * hp[:, 1:-1] + conv_w[2] * hp[:, 2:]
    return gate_b * c


def _layer(x, w_in, conv_w, g_attn, g_conv, w_o, ln1_g, ln1_b, w_gate, w_up, w_down, ln2_g, ln2_b):
    B, S, _ = x.shape
    p = x @ w_in
    A = ATTN_WIDTH
    C = CONV_WIDTH
    q = p[..., 0:A].reshape(B, S, N_ATTN_HEADS, HEAD_DIM)
    k = p[..., A:2 * A].reshape(B, S, N_ATTN_HEADS, HEAD_DIM)
    v = p[..., 2 * A:3 * A].reshape(B, S, N_ATTN_HEADS, HEAD_DIM)
    u = p[..., 3 * A:3 * A + C]
    gate_b = p[..., 3 * A + C:3 * A + 2 * C]
    gate_c = p[..., 3 * A + 2 * C:3 * A + 3 * C]
    attn = _mixed_dilated_attention(q, k, v).reshape(B, S, A)
    conv = _short_conv(u, gate_b, gate_c, conv_w)
    mix = jnp.concatenate([_rmsnorm(attn, g_attn), _rmsnorm(conv, g_conv)], axis=-1) @ w_o
    x = _layernorm(ALPHA * x + mix, ln1_g, ln1_b)
    ffn = (jax.nn.silu(x @ w_gate) * (x @ w_up)) @ w_down
    x = _layernorm(ALPHA * x + ffn, ln2_g, ln2_b)
    return x


def setup_inputs(seed: int = 0) -> dict:
    key = jax.random.key(seed)
    ks = jax.random.split(key, 16)
    f32 = jnp.float32
    nrm = lambda k, s: jax.random.normal(k, s, dtype=f32)
    return {
        "x_prompt": nrm(ks[0], (BATCH, SEQ, D_MODEL)),
        "x_sample": nrm(ks[1], (DEC_BATCH, DEC_SEQ, D_MODEL)),
        "w_in": nrm(ks[2], (D_MODEL, IN_WIDTH)) * D_MODEL ** -0.5,
        "conv_w": nrm(ks[3], (CONV_K, CONV_WIDTH)) * CONV_K ** -0.5,
        "g_attn": 1.0 + 0.02 * nrm(ks[4], (ATTN_WIDTH,)),
        "g_conv": 1.0 + 0.02 * nrm(ks[5], (CONV_WIDTH,)),
        "w_o": nrm(ks[6], (D_MODEL, D_MODEL)) * (D_MODEL ** -0.5) * BETA,
        "ln1_g": 1.0 + 0.02 * nrm(ks[7], (D_MODEL,)),
        "ln1_b": 0.02 * nrm(ks[8], (D_MODEL,)),
        "w_gate": nrm(ks[9], (D_MODEL, D_FF)) * D_MODEL ** -0.5,
        "w_up": nrm(ks[10], (D_MODEL, D_FF)) * D_MODEL ** -0.5,
        "w_down": nrm(ks[11], (D_FF, D_MODEL)) * (D_FF ** -0.5) * BETA,
        "ln2_g": 1.0 + 0.02 * nrm(ks[12], (D_MODEL,)),
        "ln2_b": 0.02 * nrm(ks[13], (D_MODEL,)),
    }


def reference(x_prompt, x_sample, w_in, conv_w, g_attn, g_conv, w_o, ln1_g, ln1_b, w_gate, w_up, w_down, ln2_g, ln2_b):
    y_prompt = x_prompt
    y_sample = x_sample
    for _ in range(DEPTH):
        y_prompt = _layer(y_prompt, w_in, conv_w, g_attn, g_conv, w_o, ln1_g, ln1_b, w_gate, w_up, w_down, ln2_g, ln2_b)
        y_sample = _layer(y_sample, w_in, conv_w, g_attn, g_conv, w_o, ln1_g, ln1_b, w_gate, w_up, w_down, ln2_g, ln2_b)
    return (y_prompt, y_sample)
```

```cpp
#include <hip/hip_runtime.h>
#include <hip/hip_cooperative_groups.h>
#include <cstdio>
#include <cstdint>
#include <cmath>
namespace cg = cooperative_groups;
namespace pg8 {
#define PG8_LAS __attribute__((address_space(3)))
typedef unsigned short bf16_t;
typedef short bf16x8 __attribute__((ext_vector_type(8)));
typedef float f32x4 __attribute__((ext_vector_type(4)));
typedef unsigned u32x4 __attribute__((ext_vector_type(4)));
constexpr int BM = 256, BK = 64, HALF = 128, HTB = HALF * BK * 2  , STAGE_BYTES = 8 * HTB, NXCD = 8, WGM = 8;

__host__ __device__ __forceinline__ int lds_byte(int r, int c) { const int st = (r >> 4) * 2 + (c >> 5), rr = r & 15, cc = c & 31, ob = rr * 64 + cc * 2; return st * 1024 + (ob ^ (((ob >> 9) & 1) << 5)); }
__host__ __device__ __forceinline__ void stage_rc(int b, int& R, int& C) { const int st = b / 1024, sb = b % 1024, swz = sb ^ (((sb >> 9) & 1) << 5); R = (st >> 1) * 16 + swz / 64; C = (st & 1) * 32 + (swz % 64) / 2; }
__host__ __device__ __forceinline__ int perm32(int rho) { const int n = rho >> 4, i = rho & 15; return 8 * (i >> 2) + 4 * n + (i & 3); }

struct Unit { int pm, pn; };
struct Gemm { const bf16_t* A; const bf16_t* Bt; int M, N, K; };

struct StaticOrder {
    int nM, nN, nwg, G, c;
    __host__ __device__ void init(int M, int N, int G_, int c_) { nM = M / BM; nN = N / BM; nwg = nM * nN; G = G_; c = c_; }
    __host__ __device__ bool next(int i, Unit& u) const {
        const long L = (long)i * G + c; if (L >= nwg) return false;
        int wgid = (int)L; { const int q = nwg / NXCD, r = nwg % NXCD, xcd = wgid % NXCD, off = wgid / NXCD; wgid = (xcd < r ? xcd * (q + 1) : r * (q + 1) + (xcd - r) * q) + off; }
        const int nig = WGM * nN, gid = wgid / nig, fm = gid * WGM, gsz = (nM - fm) < WGM ? (nM - fm) : WGM;
        u.pm = fm + ((wgid % nig) % gsz); u.pn = (wgid % nig) / gsz; return true;
    }
    __device__ __forceinline__ void a_ready(const Unit&) const {}
    __device__ __forceinline__ void done(const Unit&) const {}
};
__device__ __forceinline__ unsigned cvt_pk_bf16(float lo, float hi) { unsigned r; asm volatile("v_cvt_pk_bf16_f32 %0, %1, %2" : "=v"(r) : "v"(lo), "v"(hi)); return r; }
typedef float f32x2 __attribute__((ext_vector_type(2)));

struct EpiStoreBf16 {
    static constexpr bool PERM = true, AFTER_DRAIN = false;
    bf16_t* O; int ldc;
    __device__ __forceinline__ void operator()(const f32x4 (&acc)[2][2][4][2], const Unit& u, int wr, int wc, int fr, int fq) const {
        const int row0 = u.pm * BM + wr * 64 + fr, col0 = u.pn * BM + wc * 32 + 8 * fq;
#pragma unroll
        for (int ai = 0; ai < 2; ++ai)
#pragma unroll
            for (int m = 0; m < 4; ++m) { bf16_t* rowp = O + (size_t)(row0 + ai * HALF + m * 16) * ldc + col0;
#pragma unroll
                for (int bj = 0; bj < 2; ++bj) { const f32x4 v0 = acc[ai][bj][m][0], v1 = acc[ai][bj][m][1];
                    u32x4 w; w.x = cvt_pk_bf16(v0[0], v0[1]); w.y = cvt_pk_bf16(v0[2], v0[3]); w.z = cvt_pk_bf16(v1[0], v1[1]); w.w = cvt_pk_bf16(v1[2], v1[3]);
                    *(u32x4*)(rowp + bj * HALF) = w; } }
    }
};
__device__ __forceinline__ float swiglu1(float g, float u) { return g * u * __builtin_amdgcn_rcpf(1.0f + __builtin_amdgcn_exp2f(-1.4426950408889634f * g)); }
struct EpiSwiglu {
    static constexpr bool PERM = true, AFTER_DRAIN = false;
    bf16_t* O; int ldc;
    __device__ __forceinline__ void operator()(const f32x4 (&acc)[2][2][4][2], const Unit& u, int wr, int wc, int fr, int fq) const {
        const int row0 = u.pm * BM + wr * 64 + fr, col0 = u.pn * HALF + wc * 32 + 8 * fq;
#pragma unroll
        for (int ai = 0; ai < 2; ++ai)
#pragma unroll
            for (int m = 0; m < 4; ++m) { bf16_t* rowp = O + (size_t)(row0 + ai * HALF + m * 16) * ldc + col0;
                const f32x4 g0 = acc[ai][0][m][0], g1 = acc[ai][0][m][1], u0 = acc[ai][1][m][0], u1 = acc[ai][1][m][1];
                u32x4 w; w.x = cvt_pk_bf16(swiglu1(g0[0], u0[0]), swiglu1(g0[1], u0[1])); w.y = cvt_pk_bf16(swiglu1(g0[2], u0[2]), swiglu1(g0[3], u0[3]));
                w.z = cvt_pk_bf16(swiglu1(g1[0], u1[0]), swiglu1(g1[1], u1[1])); w.w = cvt_pk_bf16(swiglu1(g1[2], u1[2]), swiglu1(g1[3], u1[3]));
                *(u32x4*)rowp = w; }
    }
};
template <bool BASE_BF16> struct EpiRes {
    static constexpr bool PERM = false, AFTER_DRAIN = false;
    const void* base0; const void* base1; int split; float* out; float alpha;
    __device__ __forceinline__ void operator()(const f32x4 (&acc)[2][2][4][2], const Unit& u, int wr, int wc, int fr, int fq) const {
        const int rowt = u.pm * BM, col0 = u.pn * BM + wc * 32 + 4 * fq;
        const float* bf = (rowt < split) ? (const float*)base0 + (size_t)rowt * 1024 : (const float*)base1 + (size_t)(rowt - split) * 1024;
        const bf16_t* bh = (const bf16_t*)base0 + (size_t)rowt * 1024;
        float* op = out + (size_t)rowt * 1024;
#pragma unroll
        for (int ai = 0; ai < 2; ++ai)
#pragma unroll
            for (int m = 0; m < 4; ++m) { const int r = ai * HALF + wr * 64 + m * 16 + fr;
#pragma unroll
                for (int bj = 0; bj < 2; ++bj)
#pragma unroll
                    for (int n = 0; n < 2; ++n) { const int c = col0 + bj * HALF + n * 16; f32x4 x;
                        if (BASE_BF16) { const unsigned long long w = *(const unsigned long long*)(bh + (size_t)r * 1024 + c);
                            x[0] = __uint_as_float((unsigned)(w & 0xffffu) << 16); x[1] = __uint_as_float((unsigned)(w >> 16) << 16); x[2] = __uint_as_float((unsigned)((w >> 32) & 0xffffu) << 16); x[3] = __uint_as_float((unsigned)(w >> 48) << 16); }
                        else x = *(const f32x4*)(bf + (size_t)r * 1024 + c);
                        *(f32x4*)(op + (size_t)r * 1024 + c) = x * alpha + acc[ai][bj][m][n]; }
                asm volatile("" ::: "memory"); }
    }
};
template <class Epi, class Sched, bool ALIGN_EPI = false, bool SP2 = false>
__device__ __forceinline__ void gemm_phase(PG8_LAS unsigned char* lds, const Gemm g, const Sched& S, const Epi& E) {
    const int tid = threadIdx.x, wid = __builtin_amdgcn_readfirstlane(tid >> 6), lane = tid & 63, wr = wid >> 2, wc = wid & 3, fr = lane & 15, fq = lane >> 4;
    const int K = g.K, nt = K / BK;
    unsigned voffA[2], voffB[2];
#pragma unroll
    for (int i = 0; i < 2; ++i) { int R, C; stage_rc(tid * 16 + i * 8192, R, C); const int Rb = Epi::PERM ? ((R & ~31) + perm32(R & 31)) : R;
        voffA[i] = (unsigned)(R * K + C) * 2u; voffB[i] = (unsigned)(Rb * K + C) * 2u; }
    const size_t kstep = (size_t)(BK * 2);
    const size_t hstep = (size_t)HALF * K * 2;
    const size_t tstep = 2 * hstep;
    const unsigned ldsw = (unsigned)wid * 1024u;
    const int aoff = lds_byte(wr * 64 + fr, fq * 8), boff = lds_byte(wc * 32 + fr, fq * 8);
#define PG8_SA(b, h) (((b) * 2 + (h)) * HTB)
#define PG8_SB(b, h) ((4 + (b) * 2 + (h)) * HTB)
#define PG8_STAGE(bufoff, gbase, voff) do { _Pragma("unroll") for (int _i = 0; _i < 2; ++_i) \
        __builtin_amdgcn_global_load_lds((const unsigned*)((const char*)(gbase) + (voff)[_i]), (PG8_LAS unsigned*)(lds + (bufoff) + ldsw + _i * 8192), 16, 0, 0); } while (0)
#define PG8_LDA(dst, b, h) do { _Pragma("unroll") for (int m = 0; m < 4; ++m) _Pragma("unroll") for (int k = 0; k < 2; ++k) dst[m][k] = *(const PG8_LAS bf16x8*)(lds + PG8_SA(b, h) + aoff + m * 2048 + k * 1024); } while (0)
#define PG8_LDB(dst, b, h) do { _Pragma("unroll") for (int n = 0; n < 2; ++n) _Pragma("unroll") for (int k = 0; k < 2; ++k) dst[n][k] = *(const PG8_LAS bf16x8*)(lds + PG8_SB(b, h) + boff + n * 2048 + k * 1024); } while (0)
#define PG8_MMA(ai, bj, At, Bt) do { __builtin_amdgcn_s_setprio(1); _Pragma("unroll") for (int m = 0; m < 4; ++m) _Pragma("unroll") for (int n = 0; n < 2; ++n) _Pragma("unroll") for (int k = 0; k < 2; ++k) \
        acc[ai][bj][m][n] = __builtin_amdgcn_mfma_f32_16x16x32_bf16(Bt[n][k], At[m][k], acc[ai][bj][m][n], 0, 0, 0); __builtin_amdgcn_s_setprio(0); } while (0)
#define PG8_WAIT_V(n) asm volatile("s_waitcnt vmcnt(" #n ")" ::: "memory")
#define PG8_WAIT_L(n) asm volatile("s_waitcnt lgkmcnt(" #n ")" ::: "memory")
#define PG8_BAR __builtin_amdgcn_s_barrier()
#define PG8_SCHED __builtin_amdgcn_sched_barrier(0)
    Unit cur, nxt; int ui = 0;
    if (!S.next(0, cur)) return;
    f32x4 acc[2][2][4][2];
#pragma unroll
    for (int a = 0; a < 2; ++a)
#pragma unroll
        for (int b = 0; b < 2; ++b)
#pragma unroll
            for (int m = 0; m < 4; ++m)
#pragma unroll
                for (int n = 0; n < 2; ++n) acc[a][b][m][n] = (f32x4){0.f, 0.f, 0.f, 0.f};
    bf16x8 At[4][2], B0[2][2], B1[2][2];
    const char* cA = (const char*)g.A + (size_t)cur.pm * tstep; const char* cB = (const char*)g.Bt + (size_t)cur.pn * tstep;
    S.a_ready(cur);
    if constexpr (SP2) {
        PG8_STAGE(PG8_SB(0, 0), cB, voffB); PG8_STAGE(PG8_SB(0, 1), cB + hstep, voffB); PG8_STAGE(PG8_SA(0, 0), cA, voffA); PG8_STAGE(PG8_SA(0, 1), cA + hstep, voffA);
        if (wr == 1) PG8_BAR;
        PG8_WAIT_V(2); PG8_BAR;
        PG8_STAGE(PG8_SB(1, 0), cB + kstep, voffB); PG8_STAGE(PG8_SA(1, 0), cA + kstep, voffA); PG8_STAGE(PG8_SB(1, 1), cB + hstep + kstep, voffB);
        PG8_WAIT_V(6); PG8_BAR;
    } else {
        PG8_STAGE(PG8_SB(0, 0), cB, voffB); PG8_STAGE(PG8_SA(0, 0), cA, voffA); PG8_STAGE(PG8_SB(0, 1), cB + hstep, voffB); PG8_STAGE(PG8_SA(0, 1), cA + hstep, voffA);
        if (wr == 1) PG8_BAR;
        PG8_WAIT_V(4); PG8_BAR;
        PG8_STAGE(PG8_SB(1, 0), cB + kstep, voffB); PG8_STAGE(PG8_SA(1, 0), cA + kstep, voffA); PG8_STAGE(PG8_SB(1, 1), cB + hstep + kstep, voffB);
        PG8_WAIT_V(6); PG8_BAR;
    }
    for (;;) {
        const bool has_next = S.next(ui + 1, nxt);
        const char* nA = has_next ? (const char*)g.A + (size_t)nxt.pm * tstep : cA; const char* nB = has_next ? (const char*)g.Bt + (size_t)nxt.pn * tstep : cB;
        for (int t = 0; t < nt; t += 2) {
            const bool last = (t == nt - 2);
            const char* a1 = cA + (size_t)(t + 1) * kstep;
            const char* a2 = last ? nA : cA + (size_t)(t + 2) * kstep; const char* b2 = last ? nB : cB + (size_t)(t + 2) * kstep;
            const char* a3 = a2 + kstep; const char* b3 = b2 + kstep;
            if (last && has_next) S.a_ready(nxt);
            if constexpr (SP2) {
            PG8_LDB(B0, 0, 0); PG8_LDB(B1, 0, 1); PG8_SCHED; PG8_LDA(At, 0, 0); PG8_STAGE(PG8_SA(1, 1), a1 + hstep, voffA);
            PG8_WAIT_V(8); PG8_WAIT_L(0); PG8_BAR; PG8_MMA(0, 0, At, B0); PG8_MMA(0, 1, At, B1); PG8_BAR; PG8_SCHED;
            PG8_LDA(At, 0, 1); PG8_STAGE(PG8_SB(0, 0), b2, voffB); PG8_STAGE(PG8_SB(0, 1), b2 + hstep, voffB); PG8_STAGE(PG8_SA(0, 0), a2, voffA);
            PG8_WAIT_V(8); PG8_WAIT_L(0); PG8_BAR; PG8_MMA(1, 0, At, B0); PG8_MMA(1, 1, At, B1); PG8_BAR; PG8_SCHED;
            PG8_LDB(B0, 1, 0); PG8_LDB(B1, 1, 1); PG8_SCHED; PG8_LDA(At, 1, 0); PG8_STAGE(PG8_SA(0, 1), a2 + hstep, voffA);
            PG8_WAIT_V(8); PG8_WAIT_L(0); PG8_BAR; PG8_MMA(0, 0, At, B0); PG8_MMA(0, 1, At, B1); PG8_BAR; PG8_SCHED;
            PG8_LDA(At, 1, 1); PG8_STAGE(PG8_SB(1, 0), b3, voffB); PG8_STAGE(PG8_SB(1, 1), b3 + hstep, voffB); PG8_STAGE(PG8_SA(1, 0), a3, voffA);
            PG8_WAIT_V(8); PG8_WAIT_L(0); PG8_BAR; PG8_MMA(1, 0, At, B0); PG8_MMA(1, 1, At, B1); PG8_BAR; PG8_SCHED;
            } else {
            PG8_LDB(B0, 0, 0); PG8_SCHED; PG8_LDA(At, 0, 0); PG8_STAGE(PG8_SA(1, 1), a1 + hstep, voffA);
            PG8_WAIT_L(8); PG8_BAR; PG8_WAIT_L(0); PG8_MMA(0, 0, At, B0); PG8_BAR; PG8_SCHED;
            PG8_LDB(B1, 0, 1); PG8_STAGE(PG8_SB(0, 0), b2, voffB);
            PG8_BAR; PG8_WAIT_L(0); PG8_MMA(0, 1, At, B1); PG8_BAR;
            PG8_LDA(At, 0, 1); PG8_STAGE(PG8_SA(0, 0), a2, voffA);
            PG8_BAR; PG8_WAIT_L(0); PG8_MMA(1, 0, At, B0); PG8_BAR; PG8_SCHED;
            PG8_STAGE(PG8_SB(0, 1), b2 + hstep, voffB);
            PG8_WAIT_V(6); PG8_BAR; PG8_MMA(1, 1, At, B1); PG8_BAR;
            PG8_LDB(B0, 1, 0); PG8_SCHED; PG8_LDA(At, 1, 0); PG8_STAGE(PG8_SA(0, 1), a2 + hstep, voffA);
            PG8_WAIT_L(8); PG8_BAR; PG8_WAIT_L(0); PG8_MMA(0, 0, At, B0); PG8_BAR; PG8_SCHED;
            PG8_LDB(B1, 1, 1); PG8_STAGE(PG8_SB(1, 0), b3, voffB);
            PG8_BAR; PG8_WAIT_L(0); PG8_MMA(0, 1, At, B1); PG8_BAR;
            PG8_LDA(At, 1, 1); PG8_STAGE(PG8_SA(1, 0), a3, voffA);
            PG8_BAR; PG8_WAIT_L(0); PG8_MMA(1, 0, At, B0); PG8_BAR; PG8_SCHED;
            PG8_STAGE(PG8_SB(1, 1), b3 + hstep, voffB);
            PG8_WAIT_V(6); PG8_BAR; PG8_MMA(1, 1, At, B1); PG8_BAR;
            }
        }
        if constexpr (ALIGN_EPI) { if (wr == 0) PG8_BAR; }
        if constexpr (!Epi::AFTER_DRAIN) { E(acc, cur, wr, wc, fr, fq); S.done(cur); }
        if (!has_next) break;
#pragma unroll
        for (int a = 0; a < 2; ++a)
#pragma unroll
            for (int b = 0; b < 2; ++b)
#pragma unroll
                for (int m = 0; m < 4; ++m)
#pragma unroll
                    for (int n = 0; n < 2; ++n) acc[a][b][m][n] = (f32x4){0.f, 0.f, 0.f, 0.f};
        cur = nxt; cA = nA; cB = nB; ++ui;
        if constexpr (ALIGN_EPI) { if (wr == 1) PG8_BAR; }
    }
    PG8_WAIT_V(0);
    if constexpr (!ALIGN_EPI) { if (wr == 0) PG8_BAR; }
    PG8_BAR;
    if constexpr (Epi::AFTER_DRAIN) { E.fused(acc, cur, wr, wc, fr, fq, lds, wid, lane); S.done(cur); }
#undef PG8_SA
#undef PG8_SB
#undef PG8_STAGE
#undef PG8_LDA
#undef PG8_LDB
#undef PG8_MMA
#undef PG8_WAIT_V
#undef PG8_WAIT_L
#undef PG8_BAR
#undef PG8_SCHED
}
}

constexpr int NWAVES = 8;
constexpr int DM = 1024, MTOT = 65536, MP = 32768, NIN = 3072, FF = 2816, NGU = 2 * FF;
constexpr float LN_EPS = 1e-5f, ALPHA = 1.189207115002721f  , LOG2E = 1.4426950408889634f;
constexpr size_t MiB = 1u << 20;
constexpr size_t WS_WIN = 1 * MiB, WS_WO = 7 * MiB, WS_WGU = 9 * MiB, WS_WD = 20 * MiB;
constexpr size_t WS_P = 32 * MiB;
constexpr size_t WS_Y1 = 160 * MiB;
constexpr size_t WS_X1B = 32 * MiB;
constexpr size_t WS_H = 160 * MiB;
constexpr size_t WS_END = 512 * MiB;
constexpr int RING_BYTES = 131072, XCH_OFF = RING_BYTES, LDS_BYTES = 147456;

#define GAS __attribute__((address_space(1)))
#define LAS __attribute__((address_space(3)))
typedef unsigned short bf16;
typedef unsigned v4u __attribute__((ext_vector_type(4)));
typedef unsigned v2u __attribute__((ext_vector_type(2)));
typedef float f32x4 __attribute__((ext_vector_type(4)));
typedef float f32x16 __attribute__((ext_vector_type(16)));
typedef short bf16x8 __attribute__((ext_vector_type(8)));
typedef short v4i16_t __attribute__((ext_vector_type(4)));
#define LDS_WAIT() asm volatile("s_waitcnt lgkmcnt(0)" ::: "memory")
__device__ __forceinline__ unsigned f2bf(float f) { unsigned u = __builtin_bit_cast(unsigned, f); return (u + 0x7fffu + ((u >> 16) & 1u)) >> 16; }
__device__ __forceinline__ unsigned pk2(float lo, float hi) { return f2bf(lo) | (f2bf(hi) << 16); }
__device__ __forceinline__ float bflo(unsigned w) { return __uint_as_float(w << 16); }
__device__ __forceinline__ float bfhi(unsigned w) { return __uint_as_float(w & 0xffff0000u); }
__device__ __forceinline__ float wave_sum(float v) {
#pragma unroll
    for (int o = 1; o < 64; o <<= 1) v += __shfl_xor(v, o);
    return v;
}

__device__ __forceinline__ void transpose_item(const float* W, int K, int N, bf16* WT, int mode, LAS float* scr, int item, int lane) {
    const int nblk = N / 32, kb = item / nblk, nb = item % nblk, k0 = 64 * kb, n0 = 32 * nb;
#pragma unroll 8
    for (int i = 0; i < 32; ++i) { const int kk = 2 * i + (lane >> 5); scr[kk * 33 + (lane & 31)] = W[(size_t)(k0 + kk) * N + n0 + (lane & 31)]; }
    LDS_WAIT(); asm volatile("" ::: "memory");
    const int rb = (mode == 0) ? n0 : (2 * (n0 & ~127) + (n0 & 127) + (mode == 2 ? 128 : 0));
    const int c = lane & 7;
#pragma unroll
    for (int j = 0; j < 4; ++j) { const int n = (lane >> 3) + 8 * j; const LAS float* s = scr + (8 * c) * 33 + n;
        v4u o; o.x = pk2(s[0 * 33], s[1 * 33]); o.y = pk2(s[2 * 33], s[3 * 33]); o.z = pk2(s[4 * 33], s[5 * 33]); o.w = pk2(s[6 * 33], s[7 * 33]);
        *(v4u*)(WT + (size_t)(rb + n) * K + k0 + 8 * c) = o; }
    LDS_WAIT(); asm volatile("" ::: "memory");
}

__device__ __forceinline__ void attn_task(const bf16* __restrict__ P, bf16* __restrict__ MIX, const float* __restrict__ g_attn, LAS unsigned char* lds,
                                          int row0, int r, int wave, int lane, int parity) {
    const int i = lane & 31, hi = lane >> 5, h = wave;
    const int S = row0 < MP ? 4096 : 16384;
    const int seq_lo = row0 & ~(S - 1), seq_hi = seq_lo + S;
    const int qtok = row0 + r + 16 * i;
    LAS unsigned char* wl = lds + wave * 16384;
    bf16x8 qf[4];
    { const bf16* qp = P + (size_t)qtok * NIN + h * 64 + hi * 8;
#pragma unroll
      for (int d0 = 0; d0 < 4; ++d0) qf[d0] = *(const bf16x8*)(qp + 16 * d0); }
    const float slope2 = __builtin_amdgcn_exp2f(-(float)(h + 1)) * LOG2E;
    const float cs = 0.125f * LOG2E;
    f32x16 o0, o1;
#pragma unroll
    for (int k = 0; k < 16; ++k) { o0[k] = 0.f; o1[k] = 0.f; }
    float mref = 0.f, l = 0.f;
    const int kkey = lane >> 3, kchA = (lane & 7) ^ (lane >> 4);
    const int vkey = (lane & 31) >> 2, vch = ((lane >> 5) & 1) * 4 + (lane & 3);
    const char* Pk = (const char*)P + (size_t)(512 + h * 64) * 2;
    const char* Pv = (const char*)P + (size_t)(1024 + h * 64) * 2 + vch * 16;
    const int tokb = row0 + r;
#define CH_PARAMS(c, D, dl0) int D, dl0; if ((c) < 5) { D = 16; dl0 = -1024 + 512 * (c); } else if ((c) < 13) { D = 4; dl0 = -256 + 128 * ((c) - 5); } else { D = 1; dl0 = -64 + 32 * ((c) - 13); }
#define ISSUE(c, b) do { CH_PARAMS(c, D_, dl_) const int t0_ = tokb + dl_; \
        _Pragma("unroll") for (int n = 0; n < 4; ++n) { int tk = t0_ + D_ * (8 * n + kkey); tk = tk < seq_lo ? seq_lo : (tk >= seq_hi ? seq_hi - 1 : tk); \
            __builtin_amdgcn_global_load_lds((const unsigned*)(Pk + (size_t)tk * (NIN * 2) + (((n & 1) ? (kchA ^ 4) : kchA) << 4)), (LAS unsigned*)(wl + (b) * 8192 + n * 1024), 16, 0, 0); } \
        _Pragma("unroll") for (int n = 0; n < 4; ++n) { int tv = t0_ + D_ * (8 * n + vkey); tv = tv < seq_lo ? seq_lo : (tv >= seq_hi ? seq_hi - 1 : tv); \
            __builtin_amdgcn_global_load_lds((const unsigned*)(Pv + (size_t)tv * (NIN * 2)), (LAS unsigned*)(wl + (b) * 8192 + 4096 + n * 1024), 16, 0, 0); } } while (0)
    LDS_WAIT();
    ISSUE(0, 0);
    const int koff = i * 128, ksw = (i >> 1) & 7;
    const int voff = (4 * hi + ((lane & 15) >> 2)) * 64 + ((lane >> 4) & 1) * 32 + (lane & 3) * 8;
    for (int c = 0; c < 33; ++c) {
        const int b = c & 1;
        LDS_WAIT();
        if (c + 1 < 33) { ISSUE(c + 1, b ^ 1); asm volatile("s_waitcnt vmcnt(8)" ::: "memory"); }
        else asm volatile("s_waitcnt vmcnt(0)" ::: "memory");
        const LAS unsigned char* kb = wl + b * 8192 + koff;
        f32x16 s;
#pragma unroll
        for (int k = 0; k < 16; ++k) s[k] = 0.f;
#pragma unroll
        for (int d0 = 0; d0 < 4; ++d0) { const bf16x8 kf = *(const LAS bf16x8*)(kb + (((2 * d0 + hi) ^ ksw) << 4)); s = __builtin_amdgcn_mfma_f32_32x32x16_bf16(kf, qf[d0], s, 0, 0, 0); }
        CH_PARAMS(c, D, dl0)
        const float Df = (float)D, Xf = (float)(16 * i - dl0 - 4 * D * hi);
        const float xlo = fmaxf(-64.f * Df, (float)(qtok - seq_hi + 1)), xhi = fminf(64.f * Df, (float)(qtok - seq_lo));
        float cmax = -INFINITY;
#pragma unroll
        for (int rr = 0; rr < 16; ++rr) { const float crr = (float)((rr & 3) + 8 * (rr >> 2));
            const float xf = fmaf(Df, -crr, Xf);
            float tv = fmaf(s[rr], cs, fmaf(fabsf(xf), -slope2, -mref));
            tv = (xf >= xlo && xf <= xhi) ? tv : -INFINITY;
            s[rr] = tv; cmax = fmaxf(cmax, tv); }
        cmax = fmaxf(cmax, __shfl_xor(cmax, 32));
        if (__any(cmax > 8.f)) {
            const float dl = cmax > 8.f ? cmax : 0.f; mref += dl;
            const float f = __builtin_amdgcn_exp2f(-dl); l *= f;
#pragma unroll
            for (int k = 0; k < 16; ++k) { s[k] -= dl; o0[k] *= f; o1[k] *= f; }
        }
        float ps = 0.f;
#pragma unroll
        for (int k = 0; k < 16; ++k) { s[k] = __builtin_amdgcn_exp2f(s[k]); ps += s[k]; }
        l += ps;
        v4u pw0, pw1;
        pw0.x = pg8::cvt_pk_bf16(s[0], s[1]); pw0.y = pg8::cvt_pk_bf16(s[2], s[3]); pw0.z = pg8::cvt_pk_bf16(s[4], s[5]); pw0.w = pg8::cvt_pk_bf16(s[6], s[7]);
        pw1.x = pg8::cvt_pk_bf16(s[8], s[9]); pw1.y = pg8::cvt_pk_bf16(s[10], s[11]); pw1.z = pg8::cvt_pk_bf16(s[12], s[13]); pw1.w = pg8::cvt_pk_bf16(s[14], s[15]);
        const bf16x8 pb0 = __builtin_bit_cast(bf16x8, pw0), pb1 = __builtin_bit_cast(bf16x8, pw1);
        const LAS unsigned char* vb = wl + b * 8192 + 4096 + voff;
#define VTR(off) __builtin_amdgcn_ds_read_tr16_b64_v4i16((LAS v4i16_t*)(vb + (off)))
#define VFR(st, d0) ({ const v4i16_t lo_ = VTR((4 * (st) + (d0)) * 512), hi_ = VTR((4 * (st) + (d0)) * 512 + 1024); (bf16x8){lo_[0], lo_[1], lo_[2], lo_[3], hi_[0], hi_[1], hi_[2], hi_[3]}; })
        { const bf16x8 v00 = VFR(0, 0), v01 = VFR(0, 1), v10 = VFR(1, 0), v11 = VFR(1, 1);
          o0 = __builtin_amdgcn_mfma_f32_32x32x16_bf16(v00, pb0, o0, 0, 0, 0); o1 = __builtin_amdgcn_mfma_f32_32x32x16_bf16(v01, pb0, o1, 0, 0, 0);
          o0 = __builtin_amdgcn_mfma_f32_32x32x16_bf16(v10, pb1, o0, 0, 0, 0); o1 = __builtin_amdgcn_mfma_f32_32x32x16_bf16(v11, pb1, o1, 0, 0, 0); }
#undef VFR
#undef VTR
    }
#undef ISSUE
#undef CH_PARAMS
    l += __shfl_xor(l, 32);
    const float inv = 1.0f / l;
    float ssq = 0.f;
#pragma unroll
    for (int k = 0; k < 16; ++k) { o0[k] *= inv; o1[k] *= inv; ssq += o0[k] * o0[k] + o1[k] * o1[k]; }
    ssq += __shfl_xor(ssq, 32);
    LAS float* xch = (LAS float*)(lds + XCH_OFF + parity * 1024);
    if (hi == 0) xch[h * 32 + i] = ssq;
    __syncthreads();
    float tot = 0.f;
#pragma unroll
    for (int hh = 0; hh < 8; ++hh) tot += xch[hh * 32 + i];
    const float rstd = 1.0f / sqrtf(tot * (1.0f / 512.0f) + LN_EPS);
    LAS unsigned char* stg = wl;
#pragma unroll
    for (int d0 = 0; d0 < 2; ++d0)
#pragma unroll
        for (int g4 = 0; g4 < 4; ++g4) { const f32x4 gv = *(const f32x4*)(g_attn + h * 64 + 32 * d0 + 8 * g4 + 4 * hi);
            float a0, a1, a2, a3;
            if (d0 == 0) { a0 = o0[4 * g4]; a1 = o0[4 * g4 + 1]; a2 = o0[4 * g4 + 2]; a3 = o0[4 * g4 + 3]; } else { a0 = o1[4 * g4]; a1 = o1[4 * g4 + 1]; a2 = o1[4 * g4 + 2]; a3 = o1[4 * g4 + 3]; }
            v2u w; w.x = pg8::cvt_pk_bf16(a0 * rstd * gv[0], a1 * rstd * gv[1]); w.y = pg8::cvt_pk_bf16(a2 * rstd * gv[2], a3 * rstd * gv[3]);
            *(LAS v2u*)(stg + i * 144 + (32 * d0 + 8 * g4 + 4 * hi) * 2) = w; }
    LDS_WAIT();
#pragma unroll
    for (int n = 0; n < 4; ++n) { const int row = 8 * n + (lane >> 3), ch = lane & 7; const v4u v = *(const LAS v4u*)(stg + row * 144 + ch * 16);
        *(v4u*)(MIX + (size_t)(row0 + r + 16 * row) * DM + h * 64 + ch * 8) = v; }
    LDS_WAIT();
}

__device__ __forceinline__ void conv_rows(const bf16* __restrict__ P, bf16* __restrict__ MIX, const float* __restrict__ conv_w, const float* __restrict__ g_conv, int t0, int lane) {
    const int S = t0 < MP ? 4096 : 16384;
    const int seq_lo = t0 & ~(S - 1), seq_hi = seq_lo + S;
    const int ch0 = 8 * lane;
    float w0[8], w1[8], w2[8], gc[8];
#pragma unroll
    for (int j = 0; j < 2; ++j) { const f32x4 a = *(const f32x4*)(conv_w + ch0 + 4 * j), b = *(const f32x4*)(conv_w + 512 + ch0 + 4 * j), c = *(const f32x4*)(conv_w + 1024 + ch0 + 4 * j), g = *(const f32x4*)(g_conv + ch0 + 4 * j);
#pragma unroll
        for (int k = 0; k < 4; ++k) { w0[4 * j + k] = a[k]; w1[4 * j + k] = b[k]; w2[4 * j + k] = c[k]; gc[4 * j + k] = g[k]; } }
    const bf16* Pu = P + 1536 + ch0; const bf16* Pgb = P + 2048 + ch0; const bf16* Pgc = P + 2560 + ch0;
#define HROW(dst, t) do { if ((t) >= seq_lo && (t) < seq_hi) { const v4u uu = *(const v4u*)(Pu + (size_t)(t) * NIN), cc = *(const v4u*)(Pgc + (size_t)(t) * NIN); \
        dst[0] = bflo(uu.x) * bflo(cc.x); dst[1] = bfhi(uu.x) * bfhi(cc.x); dst[2] = bflo(uu.y) * bflo(cc.y); dst[3] = bfhi(uu.y) * bfhi(cc.y); \
        dst[4] = bflo(uu.z) * bflo(cc.z); dst[5] = bfhi(uu.z) * bfhi(cc.z); dst[6] = bflo(uu.w) * bflo(cc.w); dst[7] = bfhi(uu.w) * bfhi(cc.w); } \
        else { _Pragma("unroll") for (int k_ = 0; k_ < 8; ++k_) dst[k_] = 0.f; } } while (0)
    float hp[8], hc[8], hn[8];
    HROW(hp, t0 - 1); HROW(hc, t0);
    for (int t = t0; t < t0 + 32; ++t) {
        HROW(hn, t + 1);
        const v4u bb = *(const v4u*)(Pgb + (size_t)t * NIN);
        float gb[8] = {bflo(bb.x), bfhi(bb.x), bflo(bb.y), bfhi(bb.y), bflo(bb.z), bfhi(bb.z), bflo(bb.w), bfhi(bb.w)};
        float y[8]; float ssq = 0.f;
#pragma unroll
        for (int k = 0; k < 8; ++k) { y[k] = gb[k] * (w0[k] * hp[k] + w1[k] * hc[k] + w2[k] * hn[k]); ssq += y[k] * y[k]; }
        ssq = wave_sum(ssq);
        const float rstd = 1.0f / sqrtf(ssq * (1.0f / 512.0f) + LN_EPS);
        v4u o; o.x = pk2(y[0] * rstd * gc[0], y[1] * rstd * gc[1]); o.y = pk2(y[2] * rstd * gc[2], y[3] * rstd * gc[3]); o.z = pk2(y[4] * rstd * gc[4], y[5] * rstd * gc[5]); o.w = pk2(y[6] * rstd * gc[6], y[7] * rstd * gc[7]);
        *(v4u*)(MIX + (size_t)t * DM + 512 + ch0) = o;
#pragma unroll
        for (int k = 0; k < 8; ++k) { hp[k] = hc[k]; hc[k] = hn[k]; }
    }
#undef HROW
}

template <bool TO_BF16> __device__ __forceinline__ void ln_rows(const float* Y, float* OF, bf16* OB, const float* __restrict__ g, const float* __restrict__ bta, int gw, int ngw, int lane) {
    f32x4 gv[4], bv[4];
#pragma unroll
    for (int j = 0; j < 4; ++j) { gv[j] = *((const f32x4*)g + lane + 64 * j); bv[j] = *((const f32x4*)bta + lane + 64 * j); }
    for (int m = gw; m < MTOT; m += ngw) {
        const f32x4* xr = (const f32x4*)(Y + (size_t)m * DM) + lane;
        f32x4 v[4]; float s = 0.f;
#pragma unroll
        for (int j = 0; j < 4; ++j) { v[j] = xr[64 * j]; s += (v[j][0] + v[j][1]) + (v[j][2] + v[j][3]); }
        const float mean = wave_sum(s) * (1.f / DM); float s2 = 0.f;
#pragma unroll
        for (int j = 0; j < 4; ++j) { v[j] = v[j] - mean; s2 += (v[j][0] * v[j][0] + v[j][1] * v[j][1]) + (v[j][2] * v[j][2] + v[j][3] * v[j][3]); }
        const float rstd = 1.f / sqrtf(wave_sum(s2) * (1.f / DM) + LN_EPS);
#pragma unroll
        for (int j = 0; j < 4; ++j) { const f32x4 o = v[j] * rstd * gv[j] + bv[j];
            if (TO_BF16) { v2u w; w.x = pk2(o[0], o[1]); w.y = pk2(o[2], o[3]); *((v2u*)(OB + (size_t)m * DM) + lane + 64 * j) = w; }
            else *((f32x4*)(OF + (size_t)m * DM) + lane + 64 * j) = o; }
    }
}

struct Args { const float* in[14]; float* out; unsigned char* ws; };
__global__ void __launch_bounds__(NWAVES * 64, 2) hymba_fwd(Args a) {
    extern __shared__ __attribute__((aligned(16))) unsigned char lds_raw[];
    cg::grid_group grid = cg::this_grid();
    LAS unsigned char* lds = (LAS unsigned char*)lds_raw;
    const int tid = threadIdx.x, lane = tid & 63, wave = __builtin_amdgcn_readfirstlane(tid >> 6);
    const int G = gridDim.x, bx = blockIdx.x;
    const int vcu = (G % 8 == 0) ? (bx % 8) * (G / 8) + bx / 8 : bx;
    const int gw = vcu * NWAVES + wave, NGW = G * NWAVES;
    const float *x_p = a.in[0], *x_s = a.in[1], *w_in = a.in[2], *conv_w = a.in[3], *g_attn = a.in[4], *g_conv = a.in[5], *w_o = a.in[6], *ln1_g = a.in[7], *ln1_b = a.in[8],
                *w_gate = a.in[9], *w_up = a.in[10], *w_down = a.in[11], *ln2_g = a.in[12], *ln2_b = a.in[13];
    unsigned char* ws = a.ws;
    bf16 *Win_t = (bf16*)(ws + WS_WIN), *Wo_t = (bf16*)(ws + WS_WO), *Wgu_t = (bf16*)(ws + WS_WGU), *Wd_t = (bf16*)(ws + WS_WD);
    bf16 *XB = (bf16*)a.out, *MIX = (bf16*)a.out, *Pb = (bf16*)(ws + WS_P), *X1B = (bf16*)(ws + WS_X1B), *HB = (bf16*)(ws + WS_H);
    float* Y1 = (float*)(ws + WS_Y1);

    {
        LAS float* scr = (LAS float*)(lds + wave * 16384);
        constexpr int I_IN = (DM / 64) * (NIN / 32), I_O = (DM / 64) * (DM / 32), I_G = (DM / 64) * (FF / 32), I_D = (FF / 64) * (DM / 32);
        constexpr int NITEMS = I_IN + I_O + 2 * I_G + I_D;
        for (int it = gw; it < NITEMS; it += NGW) {
            int r = it;
            if (r < I_IN) { transpose_item(w_in, DM, NIN, Win_t, 0, scr, r, lane); continue; } r -= I_IN;
            if (r < I_O) { transpose_item(w_o, DM, DM, Wo_t, 0, scr, r, lane); continue; } r -= I_O;
            if (r < I_G) { transpose_item(w_gate, DM, FF, Wgu_t, 1, scr, r, lane); continue; } r -= I_G;
            if (r < I_G) { transpose_item(w_up, DM, FF, Wgu_t, 2, scr, r, lane); continue; } r -= I_G;
            transpose_item(w_down, FF, DM, Wd_t, 0, scr, r, lane);
        }
        const int gt = vcu * (NWAVES * 64) + tid, ngt = G * NWAVES * 64;
        constexpr int NGRP = MTOT * DM / 8, NGRP_P = MP * DM / 8;
        for (int q = gt; q < NGRP; q += ngt) {
            const float* src = q < NGRP_P ? x_p + (size_t)q * 8 : x_s + (size_t)(q - NGRP_P) * 8;
            const f32x4 v0 = *(const f32x4*)src, v1 = *(const f32x4*)(src + 4);
            v4u o; o.x = pk2(v0[0], v0[1]); o.y = pk2(v0[2], v0[3]); o.z = pk2(v1[0], v1[1]); o.w = pk2(v1[2], v1[3]);
            *(v4u*)(XB + (size_t)q * 8) = o;
        }
    }
    grid.sync();
    {
        pg8::Gemm g{XB, Win_t, MTOT, NIN, DM}; pg8::StaticOrder S; S.init(MTOT, NIN, G, bx);
        pg8::EpiStoreBf16 E{Pb, NIN};
        pg8::gemm_phase<pg8::EpiStoreBf16, pg8::StaticOrder, true, true>(lds, g, S, E);
    }
    grid.sync();
    {
        for (int k = 0; k < 8; ++k) { const int task = vcu * 8 + k; attn_task(Pb, MIX, g_attn, lds, (task >> 4) * 512, task & 15, wave, lane, k & 1); }
        __syncthreads();
        for (int t = gw; t < MTOT / 32; t += NGW) conv_rows(Pb, MIX, conv_w, g_conv, t * 32, lane);
    }
    grid.sync();
    {
        pg8::Gemm g{MIX, Wo_t, MTOT, DM, DM}; pg8::StaticOrder S; S.init(MTOT, DM, G, bx);
        pg8::EpiRes<false> E{x_p, x_s, MP, Y1, ALPHA};
        pg8::gemm_phase<pg8::EpiRes<false>, pg8::StaticOrder, true, true>(lds, g, S, E);
    }
    grid.sync();
    ln_rows<true>(Y1, nullptr, X1B, ln1_g, ln1_b, gw, NGW, lane);
    grid.sync();
    {
        pg8::Gemm g{X1B, Wgu_t, MTOT, NGU, DM}; pg8::StaticOrder S; S.init(MTOT, NGU, G, bx);
        pg8::EpiSwiglu E{HB, FF};
        pg8::gemm_phase<pg8::EpiSwiglu, pg8::StaticOrder, true, true>(lds, g, S, E);
    }
    grid.sync();
    {
        pg8::Gemm g{HB, Wd_t, MTOT, DM, FF}; pg8::StaticOrder S; S.init(MTOT, DM, G, bx);
        pg8::EpiRes<true> E{X1B, nullptr, MTOT, a.out, ALPHA};
        pg8::gemm_phase<pg8::EpiRes<true>, pg8::StaticOrder, true, true>(lds, g, S, E);
    }
    grid.sync();
    ln_rows<false>(a.out, a.out, nullptr, ln2_g, ln2_b, gw, NGW, lane);
}

extern "C" void kernel_launch(void* const* d_in, const int* in_sizes, int n_in, void* d_out, int out_size, void* d_ws, size_t ws_size, hipStream_t stream) {
    static int grid = 0;
    if (grid == 0) {
        if (n_in != 14 || out_size != MTOT * DM || ws_size < WS_END) { fprintf(stderr, "kernel_launch: unexpected shapes (n_in %d, out %d, ws %zu); nothing launched\n", n_in, out_size, ws_size); grid = -1; return; }
        int dev = 0, cus = 0, per_cu = 0;
        if (hipGetDevice(&dev) != hipSuccess || hipDeviceGetAttribute(&cus, hipDeviceAttributeMultiprocessorCount, dev) != hipSuccess) { grid = -1; return; }
        if (hipFuncSetAttribute((const void*)hymba_fwd, hipFuncAttributeMaxDynamicSharedMemorySize, LDS_BYTES) != hipSuccess) { fprintf(stderr, "kernel_launch: hipFuncSetAttribute failed\n"); grid = -1; return; }
        if (hipOccupancyMaxActiveBlocksPerMultiprocessor(&per_cu, (const void*)hymba_fwd, NWAVES * 64, LDS_BYTES) != hipSuccess || per_cu < 1) { fprintf(stderr, "kernel_launch: occupancy query says %d\n", per_cu); per_cu = 1; }
        (void)hipGetLastError();
        grid = cus * 1;
    }
    if (grid < 0) return;
    Args a{};
    for (int i = 0; i < 14; ++i) a.in[i] = (const float*)d_in[i];
    a.out = (float*)d_out; a.ws = (unsigned char*)d_ws;
    void* args[] = {&a};
    hipError_t e = hipLaunchCooperativeKernel((const void*)hymba_fwd, dim3(grid), dim3(NWAVES * 64), args, LDS_BYTES, stream);
    if (e != hipSuccess) fprintf(stderr, "kernel_launch: cooperative launch failed: %s (grid %d)\n", hipGetErrorString(e), grid);
}
```

```cpp
#include <hip/hip_runtime.h>
#include <hip/hip_cooperative_groups.h>
#include <cstdio>
#include <cstdint>
#include <cmath>
namespace cg = cooperative_groups;
namespace pg8 {
#define PG8_LAS __attribute__((address_space(3)))
typedef unsigned short bf16_t;
typedef short bf16x8 __attribute__((ext_vector_type(8)));
typedef float f32x4 __attribute__((ext_vector_type(4)));
typedef unsigned u32x4 __attribute__((ext_vector_type(4)));
constexpr int BM = 256, BK = 64, HALF = 128, HTB = HALF * BK * 2  , STAGE_BYTES = 8 * HTB, NXCD = 8, WGM = 8;

__host__ __device__ __forceinline__ int lds_byte(int r, int c) { const int st = (r >> 4) * 2 + (c >> 5), rr = r & 15, cc = c & 31, ob = rr * 64 + cc * 2; return st * 1024 + (ob ^ (((ob >> 9) & 1) << 5)); }
__host__ __device__ __forceinline__ void stage_rc(int b, int& R, int& C) { const int st = b / 1024, sb = b % 1024, swz = sb ^ (((sb >> 9) & 1) << 5); R = (st >> 1) * 16 + swz / 64; C = (st & 1) * 32 + (swz % 64) / 2; }
__host__ __device__ __forceinline__ int perm32(int rho) { const int n = rho >> 4, i = rho & 15; return 8 * (i >> 2) + 4 * n + (i & 3); }

struct Unit { int pm, pn; };
struct Gemm { const bf16_t* A; const bf16_t* Bt; int M, N, K; };

struct StaticOrder {
    int nM, nN, nwg, G, c;
    __host__ __device__ void init(int M, int N, int G_, int c_) { nM = M / BM; nN = N / BM; nwg = nM * nN; G = G_; c = c_; }
    __host__ __device__ bool next(int i, Unit& u) const {
        const long L = (long)i * G + c; if (L >= nwg) return false;
        int wgid = (int)L; { const int q = nwg / NXCD, r = nwg % NXCD, xcd = wgid % NXCD, off = wgid / NXCD; wgid = (xcd < r ? xcd * (q + 1) : r * (q + 1) + (xcd - r) * q) + off; }
        const int nig = WGM * nN, gid = wgid / nig, fm = gid * WGM, gsz = (nM - fm) < WGM ? (nM - fm) : WGM;
        u.pm = fm + ((wgid % nig) % gsz); u.pn = (wgid % nig) / gsz; return true;
    }
    __device__ __forceinline__ void a_ready(const Unit&) const {}
    __device__ __forceinline__ void done(const Unit&) const {}
};
__device__ __forceinline__ unsigned cvt_pk_bf16(float lo, float hi) { unsigned r; asm volatile("v_cvt_pk_bf16_f32 %0, %1, %2" : "=v"(r) : "v"(lo), "v"(hi)); return r; }
typedef float f32x2 __attribute__((ext_vector_type(2)));

struct EpiStoreBf16 {
    static constexpr bool PERM = true, AFTER_DRAIN = false;
    bf16_t* O; int ldc;
    __device__ __forceinline__ void operator()(const f32x4 (&acc)[2][2][4][2], const Unit& u, int wr, int wc, int fr, int fq) const {
        const int row0 = u.pm * BM + wr * 64 + fr, col0 = u.pn * BM + wc * 32 + 8 * fq;
#pragma unroll
        for (int ai = 0; ai < 2; ++ai)
#pragma unroll
            for (int m = 0; m < 4; ++m) { bf16_t* rowp = O + (size_t)(row0 + ai * HALF + m * 16) * ldc + col0;
#pragma unroll
                for (int bj = 0; bj < 2; ++bj) { const f32x4 v0 = acc[ai][bj][m][0], v1 = acc[ai][bj][m][1];
                    u32x4 w; w.x = cvt_pk_bf16(v0[0], v0[1]); w.y = cvt_pk_bf16(v0[2], v0[3]); w.z = cvt_pk_bf16(v1[0], v1[1]); w.w = cvt_pk_bf16(v1[2], v1[3]);
                    *(u32x4*)(rowp + bj * HALF) = w; } }
    }
};
__device__ __forceinline__ float swiglu1(float g, float u) { return g * u * __builtin_amdgcn_rcpf(1.0f + __builtin_amdgcn_exp2f(-1.4426950408889634f * g)); }
struct EpiSwiglu {
    static constexpr bool PERM = true, AFTER_DRAIN = false;
    bf16_t* O; int ldc;
    __device__ __forceinline__ void operator()(const f32x4 (&acc)[2][2][4][2], const Unit& u, int wr, int wc, int fr, int fq) const {
        const int row0 = u.pm * BM + wr * 64 + fr, col0 = u.pn * HALF + wc * 32 + 8 * fq;
#pragma unroll
        for (int ai = 0; ai < 2; ++ai)
#pragma unroll
            for (int m = 0; m < 4; ++m) { bf16_t* rowp = O + (size_t)(row0 + ai * HALF + m * 16) * ldc + col0;
                const f32x4 g0 = acc[ai][0][m][0], g1 = acc[ai][0][m][1], u0 = acc[ai][1][m][0], u1 = acc[ai][1][m][1];
                u32x4 w; w.x = cvt_pk_bf16(swiglu1(g0[0], u0[0]), swiglu1(g0[1], u0[1])); w.y = cvt_pk_bf16(swiglu1(g0[2], u0[2]), swiglu1(g0[3], u0[3]));
                w.z = cvt_pk_bf16(swiglu1(g1[0], u1[0]), swiglu1(g1[1], u1[1])); w.w = cvt_pk_bf16(swiglu1(g1[2], u1[2]), swiglu1(g1[3], u1[3]));
                *(u32x4*)rowp = w; }
    }
};
template <bool BASE_BF16> struct EpiRes {
    static constexpr bool PERM = false, AFTER_DRAIN = false;
    const void* base0; const void* base1; int split; float* out; float alpha;
    __device__ __forceinline__ void operator()(const f32x4 (&acc)[2][2][4][2], const Unit& u, int wr, int wc, int fr, int fq) const {
        const int rowt = u.pm * BM, col0 = u.pn * BM + wc * 32 + 4 * fq;
        const float* bf = (rowt < split) ? (const float*)base0 + (size_t)rowt * 1024 : (const float*)base1 + (size_t)(rowt - split) * 1024;
        const bf16_t* bh = (const bf16_t*)base0 + (size_t)rowt * 1024;
        float* op = out + (size_t)rowt * 1024;
#pragma unroll
        for (int ai = 0; ai < 2; ++ai)
#pragma unroll
            for (int m = 0; m < 4; ++m) { const int r = ai * HALF + wr * 64 + m * 16 + fr;
#pragma unroll
                for (int bj = 0; bj < 2; ++bj)
#pragma unroll
                    for (int n = 0; n < 2; ++n) { const int c = col0 + bj * HALF + n * 16; f32x4 x;
                        if (BASE_BF16) { const unsigned long long w = *(const unsigned long long*)(bh + (size_t)r * 1024 + c);
                            x[0] = __uint_as_float((unsigned)(w & 0xffffu) << 16); x[1] = __uint_as_float((unsigned)(w >> 16) << 16); x[2] = __uint_as_float((unsigned)((w >> 32) & 0xffffu) << 16); x[3] = __uint_as_float((unsigned)(w >> 48) << 16); }
                        else x = *(const f32x4*)(bf + (size_t)r * 1024 + c);
                        *(f32x4*)(op + (size_t)r * 1024 + c) = x * alpha + acc[ai][bj][m][n]; }
                asm volatile("" ::: "memory"); }
    }
};
template <class Epi, class Sched, bool ALIGN_EPI = false, bool SP2 = false>
__device__ __forceinline__ void gemm_phase(PG8_LAS unsigned char* lds, const Gemm g, const Sched& S, const Epi& E) {
    const int tid = threadIdx.x, wid = __builtin_amdgcn_readfirstlane(tid >> 6), lane = tid & 63, wr = wid >> 2, wc = wid & 3, fr = lane & 15, fq = lane >> 4;
    const int K = g.K, nt = K / BK;
    unsigned voffA[2], voffB[2];
#pragma unroll
    for (int i = 0; i < 2; ++i) { int R, C; stage_rc(tid * 16 + i * 8192, R, C); const int Rb = Epi::PERM ? ((R & ~31) + perm32(R & 31)) : R;
        voffA[i] = (unsigned)(R * K + C) * 2u; voffB[i] = (unsigned)(Rb * K + C) * 2u; }
    const size_t kstep = (size_t)(BK * 2);
    const size_t hstep = (size_t)HALF * K * 2;
    const size_t tstep = 2 * hstep;
    const unsigned ldsw = (unsigned)wid * 1024u;
    const int aoff = lds_byte(wr * 64 + fr, fq * 8), boff = lds_byte(wc * 32 + fr, fq * 8);
#define PG8_SA(b, h) (((b) * 2 + (h)) * HTB)
#define PG8_SB(b, h) ((4 + (b) * 2 + (h)) * HTB)
#define PG8_STAGE(bufoff, gbase, voff) do { _Pragma("unroll") for (int _i = 0; _i < 2; ++_i) \
        __builtin_amdgcn_global_load_lds((const unsigned*)((const char*)(gbase) + (voff)[_i]), (PG8_LAS unsigned*)(lds + (bufoff) + ldsw + _i * 8192), 16, 0, 0); } while (0)
#define PG8_LDA(dst, b, h) do { _Pragma("unroll") for (int m = 0; m < 4; ++m) _Pragma("unroll") for (int k = 0; k < 2; ++k) dst[m][k] = *(const PG8_LAS bf16x8*)(lds + PG8_SA(b, h) + aoff + m * 2048 + k * 1024); } while (0)
#define PG8_LDB(dst, b, h) do { _Pragma("unroll") for (int n = 0; n < 2; ++n) _Pragma("unroll") for (int k = 0; k < 2; ++k) dst[n][k] = *(const PG8_LAS bf16x8*)(lds + PG8_SB(b, h) + boff + n * 2048 + k * 1024); } while (0)
#define PG8_MMA(ai, bj, At, Bt) do { __builtin_amdgcn_s_setprio(1); _Pragma("unroll") for (int m = 0; m < 4; ++m) _Pragma("unroll") for (int n = 0; n < 2; ++n) _Pragma("unroll") for (int k = 0; k < 2; ++k) \
        acc[ai][bj][m][n] = __builtin_amdgcn_mfma_f32_16x16x32_bf16(Bt[n][k], At[m][k], acc[ai][bj][m][n], 0, 0, 0); __builtin_amdgcn_s_setprio(0); } while (0)
#define PG8_WAIT_V(n) asm volatile("s_waitcnt vmcnt(" #n ")" ::: "memory")
#define PG8_WAIT_L(n) asm volatile("s_waitcnt lgkmcnt(" #n ")" ::: "memory")
#define PG8_BAR __builtin_amdgcn_s_barrier()
#define PG8_SCHED __builtin_amdgcn_sched_barrier(0)
    Unit cur, nxt; int ui = 0;
    if (!S.next(0, cur)) return;
    f32x4 acc[2][2][4][2];
#pragma unroll
    for (int a = 0; a < 2; ++a)
#pragma unroll
        for (int b = 0; b < 2; ++b)
#pragma unroll
            for (int m = 0; m < 4; ++m)
#pragma unroll
                for (int n = 0; n < 2; ++n) acc[a][b][m][n] = (f32x4){0.f, 0.f, 0.f, 0.f};
    bf16x8 At[4][2], B0[2][2], B1[2][2];
    const char* cA = (const char*)g.A + (size_t)cur.pm * tstep; const char* cB = (const char*)g.Bt + (size_t)cur.pn * tstep;
    S.a_ready(cur);
    if constexpr (SP2) {
        PG8_STAGE(PG8_SB(0, 0), cB, voffB); PG8_STAGE(PG8_SB(0, 1), cB + hstep, voffB); PG8_STAGE(PG8_SA(0, 0), cA, voffA); PG8_STAGE(PG8_SA(0, 1), cA + hstep, voffA);
        if (wr == 1) PG8_BAR;
        PG8_WAIT_V(2); PG8_BAR;
        PG8_STAGE(PG8_SB(1, 0), cB + kstep, voffB); PG8_STAGE(PG8_SA(1, 0), cA + kstep, voffA); PG8_STAGE(PG8_SB(1, 1), cB + hstep + kstep, voffB);
        PG8_WAIT_V(6); PG8_BAR;
    } else {
        PG8_STAGE(PG8_SB(0, 0), cB, voffB); PG8_STAGE(PG8_SA(0, 0), cA, voffA); PG8_STAGE(PG8_SB(0, 1), cB + hstep, voffB); PG8_STAGE(PG8_SA(0, 1), cA + hstep, voffA);
        if (wr == 1) PG8_BAR;
        PG8_WAIT_V(4); PG8_BAR;
        PG8_STAGE(PG8_SB(1, 0), cB + kstep, voffB); PG8_STAGE(PG8_SA(1, 0), cA + kstep, voffA); PG8_STAGE(PG8_SB(1, 1), cB + hstep + kstep, voffB);
        PG8_WAIT_V(6); PG8_BAR;
    }
    for (;;) {
        const bool has_next = S.next(ui + 1, nxt);
        const char* nA = has_next ? (const char*)g.A + (size_t)nxt.pm * tstep : cA; const char* nB = has_next ? (const char*)g.Bt + (size_t)nxt.pn * tstep : cB;
        for (int t = 0; t < nt; t += 2) {
            const bool last = (t == nt - 2);
            const char* a1 = cA + (size_t)(t + 1) * kstep;
            const char* a2 = last ? nA : cA + (size_t)(t + 2) * kstep; const char* b2 = last ? nB : cB + (size_t)(t + 2) * kstep;
            const char* a3 = a2 + kstep; const char* b3 = b2 + kstep;
            if (last && has_next) S.a_ready(nxt);
            if constexpr (SP2) {
            PG8_LDB(B0, 0, 0); PG8_LDB(B1, 0, 1); PG8_SCHED; PG8_LDA(At, 0, 0); PG8_STAGE(PG8_SA(1, 1), a1 + hstep, voffA);
            PG8_WAIT_V(8); PG8_WAIT_L(0); PG8_BAR; PG8_MMA(0, 0, At, B0); PG8_MMA(0, 1, At, B1); PG8_BAR; PG8_SCHED;
            PG8_LDA(At, 0, 1); PG8_STAGE(PG8_SB(0, 0), b2, voffB); PG8_STAGE(PG8_SB(0, 1), b2 + hstep, voffB); PG8_STAGE(PG8_SA(0, 0), a2, voffA);
            PG8_WAIT_V(8); PG8_WAIT_L(0); PG8_BAR; PG8_MMA(1, 0, At, B0); PG8_MMA(1, 1, At, B1); PG8_BAR; PG8_SCHED;
            PG8_LDB(B0, 1, 0); PG8_LDB(B1, 1, 1); PG8_SCHED; PG8_LDA(At, 1, 0); PG8_STAGE(PG8_SA(0, 1), a2 + hstep, voffA);
            PG8_WAIT_V(8); PG8_WAIT_L(0); PG8_BAR; PG8_MMA(0, 0, At, B0); PG8_MMA(0, 1, At, B1); PG8_BAR; PG8_SCHED;
            PG8_LDA(At, 1, 1); PG8_STAGE(PG8_SB(1, 0), b3, voffB); PG8_STAGE(PG8_SB(1, 1), b3 + hstep, voffB); PG8_STAGE(PG8_SA(1, 0), a3, voffA);
            PG8_WAIT_V(8); PG8_WAIT_L(0); PG8_BAR; PG8_MMA(1, 0, At, B0); PG8_MMA(1, 1, At, B1); PG8_BAR; PG8_SCHED;
            } else {
            PG8_LDB(B0, 0, 0); PG8_SCHED; PG8_LDA(At, 0, 0); PG8_STAGE(PG8_SA(1, 1), a1 + hstep, voffA);
            PG8_WAIT_L(8); PG8_BAR; PG8_WAIT_L(0); PG8_MMA(0, 0, At, B0); PG8_BAR; PG8_SCHED;
            PG8_LDB(B1, 0, 1); PG8_STAGE(PG8_SB(0, 0), b2, voffB);
            PG8_BAR; PG8_WAIT_L(0); PG8_MMA(0, 1, At, B1); PG8_BAR;
            PG8_LDA(At, 0, 1); PG8_STAGE(PG8_SA(0, 0), a2, voffA);
            PG8_BAR; PG8_WAIT_L(0); PG8_MMA(1, 0, At, B0); PG8_BAR; PG8_SCHED;
            PG8_STAGE(PG8_SB(0, 1), b2 + hstep, voffB);
            PG8_WAIT_V(6); PG8_BAR; PG8_MMA(1, 1, At, B1); PG8_BAR;
            PG8_LDB(B0, 1, 0); PG8_SCHED; PG8_LDA(At, 1, 0); PG8_STAGE(PG8_SA(0, 1), a2 + hstep, voffA);
            PG8_WAIT_L(8); PG8_BAR; PG8_WAIT_L(0); PG8_MMA(0, 0, At, B0); PG8_BAR; PG8_SCHED;
            PG8_LDB(B1, 1, 1); PG8_STAGE(PG8_SB(1, 0), b3, voffB);
            PG8_BAR; PG8_WAIT_L(0); PG8_MMA(0, 1, At, B1); PG8_BAR;
            PG8_LDA(At, 1, 1); PG8_STAGE(PG8_SA(1, 0), a3, voffA);
            PG8_BAR; PG8_WAIT_L(0); PG8_MMA(1, 0, At, B0); PG8_BAR; PG8_SCHED;
            PG8_STAGE(PG8_SB(1, 1), b3 + hstep, voffB);
            PG8_WAIT_V(6); PG8_BAR; PG8_MMA(1, 1, At, B1); PG8_BAR;
            }
        }
        if constexpr (ALIGN_EPI) { if (wr == 0) PG8_BAR; }
        if constexpr (!Epi::AFTER_DRAIN) { E(acc, cur, wr, wc, fr, fq); S.done(cur); }
        if (!has_next) break;
#pragma unroll
        for (int a = 0; a < 2; ++a)
#pragma unroll
            for (int b = 0; b < 2; ++b)
#pragma unroll
                for (int m = 0; m < 4; ++m)
#pragma unroll
                    for (int n = 0; n < 2; ++n) acc[a][b][m][n] = (f32x4){0.f, 0.f, 0.f, 0.f};
        cur = nxt; cA = nA; cB = nB; ++ui;
        if constexpr (ALIGN_EPI) { if (wr == 1) PG8_BAR; }
    }
    PG8_WAIT_V(0);
    if constexpr (!ALIGN_EPI) { if (wr == 0) PG8_BAR; }
    PG8_BAR;
    if constexpr (Epi::AFTER_DRAIN) { E.fused(acc, cur, wr, wc, fr, fq, lds, wid, lane); S.done(cur); }
#undef PG8_SA
#undef PG8_SB
#undef PG8_STAGE
#undef PG8_LDA
#undef PG8_LDB
#undef PG8_MMA
#undef PG8_WAIT_V
#undef PG8_WAIT_L
#undef PG8_BAR
#undef PG8_SCHED
}
}

constexpr int NWAVES = 8;
constexpr int DM = 1024, MTOT = 65536, MP = 32768, NIN = 3072, FF = 2816, NGU = 2 * FF;
constexpr float LN_EPS = 1e-5f, ALPHA = 1.189207115002721f  , LOG2E = 1.4426950408889634f;
constexpr size_t MiB = 1u << 20;
constexpr size_t WS_WIN = 1 * MiB, WS_WO = 7 * MiB, WS_WGU = 9 * MiB, WS_WD = 20 * MiB;
constexpr size_t WS_P = 32 * MiB;
constexpr size_t WS_Y1 = 160 * MiB;
constexpr size_t WS_X1B = 32 * MiB;
constexpr size_t WS_H = 160 * MiB;
constexpr size_t WS_LSE = 416 * MiB;
constexpr size_t WS_END = 512 * MiB;
constexpr int RING_BYTES = 131072, XCH_OFF = RING_BYTES, MISC_OFF = RING_BYTES + 4096, LDS_BYTES = 147456;
constexpr size_t CTL_ZERO_BYTES = 65536;

#define GAS __attribute__((address_space(1)))
#define LAS __attribute__((address_space(3)))
typedef unsigned short bf16;
typedef unsigned v4u __attribute__((ext_vector_type(4)));
typedef unsigned v2u __attribute__((ext_vector_type(2)));
typedef float f32x4 __attribute__((ext_vector_type(4)));
typedef float f32x16 __attribute__((ext_vector_type(16)));
typedef short bf16x8 __attribute__((ext_vector_type(8)));
typedef short v4i16_t __attribute__((ext_vector_type(4)));
#define LDS_WAIT() asm volatile("s_waitcnt lgkmcnt(0)" ::: "memory")
__device__ __forceinline__ unsigned f2bf(float f) { unsigned u = __builtin_bit_cast(unsigned, f); return (u + 0x7fffu + ((u >> 16) & 1u)) >> 16; }
__device__ __forceinline__ unsigned pk2(float lo, float hi) { return f2bf(lo) | (f2bf(hi) << 16); }
__device__ __forceinline__ float bflo(unsigned w) { return __uint_as_float(w << 16); }
__device__ __forceinline__ float bfhi(unsigned w) { return __uint_as_float(w & 0xffff0000u); }
__device__ __forceinline__ float wave_sum(float v) {
#pragma unroll
    for (int o = 1; o < 64; o <<= 1) v += __shfl_xor(v, o);
    return v;
}

__device__ __forceinline__ void transpose_item(const float* W, int K, int N, bf16* WT, int mode, LAS float* scr, int item, int lane) {
    const int nblk = N / 32, kb = item / nblk, nb = item % nblk, k0 = 64 * kb, n0 = 32 * nb;
#pragma unroll 8
    for (int i = 0; i < 32; ++i) { const int kk = 2 * i + (lane >> 5); scr[kk * 33 + (lane & 31)] = W[(size_t)(k0 + kk) * N + n0 + (lane & 31)]; }
    LDS_WAIT(); asm volatile("" ::: "memory");
    const int rb = (mode == 0) ? n0 : (2 * (n0 & ~127) + (n0 & 127) + (mode == 2 ? 128 : 0));
    const int c = lane & 7;
#pragma unroll
    for (int j = 0; j < 4; ++j) { const int n = (lane >> 3) + 8 * j; const LAS float* s = scr + (8 * c) * 33 + n;
        v4u o; o.x = pk2(s[0 * 33], s[1 * 33]); o.y = pk2(s[2 * 33], s[3 * 33]); o.z = pk2(s[4 * 33], s[5 * 33]); o.w = pk2(s[6 * 33], s[7 * 33]);
        *(v4u*)(WT + (size_t)(rb + n) * K + k0 + 8 * c) = o; }
    LDS_WAIT(); asm volatile("" ::: "memory");
}

__device__ __forceinline__ float fma_abs1(float a, float b, float c) { float r; asm("v_fma_f32 %0, |%1|, %2, %3" : "=v"(r) : "v"(a), "v"(b), "v"(c)); return r; }
__device__ __forceinline__ float fma_s(float a, float b, float c) { float r; asm("v_fma_f32 %0, %1, %2, %3" : "=v"(r) : "v"(a), "v"(b), "v"(c)); return r; }
__device__ __forceinline__ float sub_s(float a, float b) { float r; asm("v_sub_f32 %0, %1, %2" : "=v"(r) : "v"(a), "v"(b)); return r; }
typedef float f32x2_t __attribute__((ext_vector_type(2))); typedef __bf16 bf16x2_t __attribute__((ext_vector_type(2)));
__device__ __forceinline__ unsigned cvtpk_m(float lo, float hi) { f32x2_t v = {lo, hi}; bf16x2_t b = __builtin_convertvector(v, bf16x2_t); return __builtin_bit_cast(unsigned, b); }
__device__ __forceinline__ void gld16(const char* src, LAS unsigned char* dst) { __builtin_amdgcn_global_load_lds((const unsigned*)src, (LAS unsigned*)dst, 16, 0, 0); }
template <int PASS, bool EDGE>
__device__ __forceinline__ void attn_task(const bf16* __restrict__ P, bf16* PART, float* LSE, bf16* __restrict__ MIX, const float* __restrict__ g_attn, LAS unsigned char* lds,
                                          int row0, int r, int seq_lo, int seq_hi, int wave, int lane, int parity) {
    constexpr int QS = PASS == 0 ? 16 : 1, NCH = PASS == 0 ? 13 : 5;
    const int i = lane & 31, hi = lane >> 5, h = wave;
    const int tokb = PASS == 0 ? row0 + r : row0 + 32 * r;
    const int qtok = tokb + QS * i;
    LAS unsigned char* wl = lds + wave * 16384;
    const int vkey = (lane & 31) >> 2, vch = ((lane >> 5) & 1) * 4 + (lane & 3);
    const unsigned kcolq = (unsigned)((512 + h * 64) * 2 + hi * 16), vcol = (unsigned)((1024 + h * 64) * 2 + vch * 16);
    const unsigned vkeyb = (unsigned)vkey * 6144u;
    const char* Pc = (const char*)P;
#define ATT_CH_PARAMS(c, D, dl0) int D, dl0; if (PASS == 0) { if ((c) < 5) { D = 16; dl0 = -1024 + 512 * (c); } else { D = 4; dl0 = -256 + 128 * ((c) - 5); } } else { D = 1; dl0 = -64 + 32 * (c); }
#define ATT_KLOAD(c, KF) do { ATT_CH_PARAMS(c, D_, dl_) int tk = tokb + dl_ + D_ * i; if (EDGE) tk = min(max(tk, seq_lo), seq_hi - 1); \
        const char* kp_ = Pc + (size_t)((unsigned)tk * 6144u + kcolq); \
        asm volatile("global_load_dwordx4 %0, %4, off\n\tglobal_load_dwordx4 %1, %4, off offset:32\n\tglobal_load_dwordx4 %2, %4, off offset:64\n\tglobal_load_dwordx4 %3, %4, off offset:96" \
                     : "=&v"(KF[0]), "=&v"(KF[1]), "=&v"(KF[2]), "=&v"(KF[3]) : "v"(kp_) : "memory"); } while (0)
#define ATT_KPIN(KF) do { asm volatile("" : "+v"(KF[0]), "+v"(KF[1]), "+v"(KF[2]), "+v"(KF[3]) :: "memory"); __builtin_amdgcn_sched_barrier(0); } while (0)
#define ATT_VISSUE(c, slot) do { ATT_CH_PARAMS(c, D_, dl_) const int t0_ = tokb + dl_; \
        if (EDGE) { \
            _Pragma("unroll") for (int n = 0; n < 4; ++n) { int tv = t0_ + D_ * (8 * n + vkey); tv = min(max(tv, seq_lo), seq_hi - 1); \
                gld16(Pc + (size_t)((unsigned)tv * 6144u + vcol), wl + (slot) * 4096 + n * 1024); } \
        } else { \
            const char* sb_ = Pc + (size_t)((unsigned)t0_ * 6144u); const unsigned vv_ = vkeyb * (unsigned)D_ + vcol; \
            _Pragma("unroll") for (int n = 0; n < 4; ++n) gld16(sb_ + (size_t)((unsigned)(n * 8 * D_) * 6144u) + (size_t)vv_, wl + (slot) * 4096 + n * 1024); \
        } } while (0)
    bf16x8 qf[4];
    { const bf16* qp = P + (size_t)qtok * NIN + h * 64 + hi * 8;
#pragma unroll
      for (int d0 = 0; d0 < 4; ++d0) qf[d0] = *(const bf16x8*)(qp + 16 * d0); }
    const float nslope2 = -__builtin_amdgcn_exp2f(-(float)(h + 1)) * LOG2E;
    const float cs = 0.125f * LOG2E;
    f32x16 o0, o1; float mref, l;
    if (PASS == 0) {
#pragma unroll
        for (int k = 0; k < 16; ++k) { o0[k] = 0.f; o1[k] = 0.f; }
        mref = 0.f; l = 0.f;
    } else {
        const bf16* pp = PART + (size_t)qtok * 512 + h * 64 + 4 * hi;
#pragma unroll
        for (int g4 = 0; g4 < 4; ++g4) { const v2u w0 = *(const v2u*)(pp + 8 * g4), w1 = *(const v2u*)(pp + 32 + 8 * g4);
            o0[4 * g4] = bflo(w0.x); o0[4 * g4 + 1] = bfhi(w0.x); o0[4 * g4 + 2] = bflo(w0.y); o0[4 * g4 + 3] = bfhi(w0.y);
            o1[4 * g4] = bflo(w1.x); o1[4 * g4 + 1] = bfhi(w1.x); o1[4 * g4 + 2] = bflo(w1.y); o1[4 * g4 + 3] = bfhi(w1.y); }
        mref = LSE[(size_t)qtok * 8 + h]; l = hi == 0 ? 1.f : 0.f;
    }
    asm volatile("" ::: "memory");
    LDS_WAIT();
    bf16x8 kA[4], kB[4], kC[4];
    ATT_VISSUE(0, 0); ATT_KLOAD(0, kA); ATT_VISSUE(1, 1); ATT_KLOAD(1, kB); ATT_VISSUE(2, 2);
    const int voff = (4 * hi + ((lane & 15) >> 2)) * 64 + ((lane >> 4) & 1) * 32 + (lane & 3) * 8;
#define VTR(off) __builtin_amdgcn_ds_read_tr16_b64_v4i16((LAS v4i16_t*)(vb + (off)))
#define VFR(st, d0) ({ const v4i16_t lo_ = VTR((4 * (st) + (d0)) * 512), hi_ = VTR((4 * (st) + (d0)) * 512 + 1024); (bf16x8){lo_[0], lo_[1], lo_[2], lo_[3], hi_[0], hi_[1], hi_[2], hi_[3]}; })
#define ATT_STEP(c, KUSE, KLD) do { \
        LDS_WAIT(); asm volatile("" ::: "memory"); \
        if ((c) + 2 < NCH) ATT_KLOAD((c) + 2, KLD); \
        if ((c) + 3 < NCH) ATT_VISSUE((c) + 3, ((c) + 3) & 3); \
        { const int rem_ = NCH - 1 - (c); \
          if (rem_ >= 3) asm volatile("s_waitcnt vmcnt(20)" ::: "memory"); else if (rem_ == 2) asm volatile("s_waitcnt vmcnt(16)" ::: "memory"); \
          else if (rem_ == 1) asm volatile("s_waitcnt vmcnt(8)" ::: "memory"); else asm volatile("s_waitcnt vmcnt(0)" ::: "memory"); } \
        ATT_KPIN(KUSE); \
        f32x16 s; \
        _Pragma("unroll") for (int k = 0; k < 16; ++k) s[k] = 0.f; \
        _Pragma("unroll") for (int d0 = 0; d0 < 4; ++d0) s = __builtin_amdgcn_mfma_f32_32x32x16_bf16(KUSE[d0], qf[d0], s, 0, 0, 0); \
        asm volatile("s_nop 15\n\ts_nop 7" : "+v"(s));               \
        ATT_CH_PARAMS(c, D, dl0) \
        const float Df = (float)D, Xf = (float)(QS * i - dl0 - 4 * D * hi), lim = 64.f * Df, nm = -mref; \
        const float xlo = fmaxf(-lim, (float)(qtok - seq_hi + 1)), xhi = fminf(lim, (float)(qtok - seq_lo)); \
        const float D1 = Df, D2 = 2.f * Df, D3 = 3.f * Df; \
        float cmax = -INFINITY; \
        _Pragma("unroll") for (int g = 0; g < 4; ++g) { const float Xg = Xf - 8.f * Df * (float)g; \
            _Pragma("unroll") for (int j = 0; j < 4; ++j) { const int rr = 4 * g + j; \
                const float xf = j == 0 ? Xg : sub_s(Xg, j == 1 ? D1 : (j == 2 ? D2 : D3)); \
                float tv = fma_s(s[rr], cs, fma_abs1(xf, nslope2, nm)); \
                if (EDGE) tv = (xf >= xlo && xf <= xhi) ? tv : -INFINITY; else tv = (fabsf(xf) <= lim) ? tv : -INFINITY; \
                s[rr] = tv; cmax = fmaxf(cmax, tv); } } \
        cmax = fmaxf(cmax, __shfl_xor(cmax, 32)); \
        if (__any(cmax > 8.f)) { \
            const float dl = cmax > 8.f ? cmax : 0.f; mref += dl; \
            const float f = __builtin_amdgcn_exp2f(-dl); l *= f; \
            _Pragma("unroll") for (int k = 0; k < 16; ++k) { s[k] -= dl; o0[k] *= f; o1[k] *= f; } \
        } \
        float ps = 0.f; \
        _Pragma("unroll") for (int k = 0; k < 16; ++k) { s[k] = __builtin_amdgcn_exp2f(s[k]); ps += s[k]; } \
        l += ps; \
        v4u pw0, pw1; \
        pw0.x = cvtpk_m(s[0], s[1]); pw0.y = cvtpk_m(s[2], s[3]); pw0.z = cvtpk_m(s[4], s[5]); pw0.w = cvtpk_m(s[6], s[7]); \
        pw1.x = cvtpk_m(s[8], s[9]); pw1.y = cvtpk_m(s[10], s[11]); pw1.z = cvtpk_m(s[12], s[13]); pw1.w = cvtpk_m(s[14], s[15]); \
        const bf16x8 pb0 = __builtin_bit_cast(bf16x8, pw0), pb1 = __builtin_bit_cast(bf16x8, pw1); \
        const LAS unsigned char* vb = wl + ((c) & 3) * 4096 + voff; \
        { const bf16x8 v00 = VFR(0, 0), v01 = VFR(0, 1), v10 = VFR(1, 0), v11 = VFR(1, 1); \
          o0 = __builtin_amdgcn_mfma_f32_32x32x16_bf16(v00, pb0, o0, 0, 0, 0); o1 = __builtin_amdgcn_mfma_f32_32x32x16_bf16(v01, pb0, o1, 0, 0, 0); \
          o0 = __builtin_amdgcn_mfma_f32_32x32x16_bf16(v10, pb1, o0, 0, 0, 0); o1 = __builtin_amdgcn_mfma_f32_32x32x16_bf16(v11, pb1, o1, 0, 0, 0); } \
    } while (0)
    for (int c0 = 0; c0 < NCH; c0 += 3) {
        ATT_STEP(c0, kA, kC);
        if (c0 + 1 < NCH) ATT_STEP(c0 + 1, kB, kA);
        if (c0 + 2 < NCH) ATT_STEP(c0 + 2, kC, kB);
    }
#undef ATT_STEP
#undef VFR
#undef VTR
#undef ATT_VISSUE
#undef ATT_KLOAD
#undef ATT_KPIN
#undef ATT_CH_PARAMS
    asm volatile("s_waitcnt vmcnt(0)" ::: "memory");
    l += __shfl_xor(l, 32);
    const float inv = 1.0f / l;
    float sc = inv;
    if (PASS == 0) {
        if (hi == 0) LSE[(size_t)qtok * 8 + h] = mref + __builtin_amdgcn_logf(l);
    } else {
        float ssq = 0.f;
#pragma unroll
        for (int k = 0; k < 16; ++k) { const float a = o0[k] * inv, bb = o1[k] * inv; ssq += a * a + bb * bb; }
        ssq += __shfl_xor(ssq, 32);
        LAS float* xch = (LAS float*)(lds + XCH_OFF + parity * 1024);
        if (hi == 0) xch[h * 32 + i] = ssq;
        __syncthreads();
        float tot = 0.f;
#pragma unroll
        for (int hh = 0; hh < 8; ++hh) tot += xch[hh * 32 + i];
        sc = inv / sqrtf(tot * (1.0f / 512.0f) + LN_EPS);
    }
    LAS unsigned char* stg = wl;
#pragma unroll
    for (int d0 = 0; d0 < 2; ++d0)
#pragma unroll
        for (int g4 = 0; g4 < 4; ++g4) {
            f32x4 gv = {1.f, 1.f, 1.f, 1.f};
            if (PASS == 1) gv = *(const f32x4*)(g_attn + h * 64 + 32 * d0 + 8 * g4 + 4 * hi);
            float a0, a1, a2, a3;
            if (d0 == 0) { a0 = o0[4 * g4]; a1 = o0[4 * g4 + 1]; a2 = o0[4 * g4 + 2]; a3 = o0[4 * g4 + 3]; } else { a0 = o1[4 * g4]; a1 = o1[4 * g4 + 1]; a2 = o1[4 * g4 + 2]; a3 = o1[4 * g4 + 3]; }
            v2u w; w.x = pg8::cvt_pk_bf16(a0 * sc * gv[0], a1 * sc * gv[1]); w.y = pg8::cvt_pk_bf16(a2 * sc * gv[2], a3 * sc * gv[3]);
            *(LAS v2u*)(stg + i * 144 + (32 * d0 + 8 * g4 + 4 * hi) * 2) = w; }
    LDS_WAIT();
    bf16* OUT = PASS == 0 ? PART : MIX; const int ldo = PASS == 0 ? 512 : DM;
#pragma unroll
    for (int n = 0; n < 4; ++n) { const int row = 8 * n + (lane >> 3), ch = lane & 7; const v4u v = *(const LAS v4u*)(stg + row * 144 + ch * 16);
        *(v4u*)(OUT + (size_t)(tokb + QS * row) * ldo + h * 64 + ch * 8) = v; }
    LDS_WAIT();
}
template <int PASS> __device__ __forceinline__ void attn_pass(const bf16* P, bf16* PART, float* LSE, bf16* MIX, const float* g_attn, LAS unsigned char* lds, int vcu, int wave, int lane) {
    for (int k = 0; k < 8; ++k) {
        const int task = vcu * 8 + k, row0 = (task >> 4) * 512, r = task & 15;
        const int S = row0 < MP ? 4096 : 16384, seq_lo = row0 & ~(S - 1), seq_hi = seq_lo + S;
        const bool edge = PASS == 0 ? (row0 - 1024 < seq_lo || row0 + 1536 > seq_hi) : (row0 - 64 < seq_lo || row0 + 576 > seq_hi);
        if (edge) attn_task<PASS, true>(P, PART, LSE, MIX, g_attn, lds, row0, r, seq_lo, seq_hi, wave, lane, k & 1);
        else attn_task<PASS, false>(P, PART, LSE, MIX, g_attn, lds, row0, r, seq_lo, seq_hi, wave, lane, k & 1);
    }
}

__device__ __forceinline__ void conv_rows(const bf16* __restrict__ P, bf16* __restrict__ MIX, const float* __restrict__ conv_w, const float* __restrict__ g_conv, int t0, int lane) {
    const int S = t0 < MP ? 4096 : 16384;
    const int seq_lo = t0 & ~(S - 1), seq_hi = seq_lo + S;
    const int ch0 = 8 * lane;
    float w0[8], w1[8], w2[8], gc[8];
#pragma unroll
    for (int j = 0; j < 2; ++j) { const f32x4 a = *(const f32x4*)(conv_w + ch0 + 4 * j), b = *(const f32x4*)(conv_w + 512 + ch0 + 4 * j), c = *(const f32x4*)(conv_w + 1024 + ch0 + 4 * j), g = *(const f32x4*)(g_conv + ch0 + 4 * j);
#pragma unroll
        for (int k = 0; k < 4; ++k) { w0[4 * j + k] = a[k]; w1[4 * j + k] = b[k]; w2[4 * j + k] = c[k]; gc[4 * j + k] = g[k]; } }
    const bf16* Pu = P + 1536 + ch0; const bf16* Pgb = P + 2048 + ch0; const bf16* Pgc = P + 2560 + ch0;
#define HROW(dst, t) do { if ((t) >= seq_lo && (t) < seq_hi) { const v4u uu = *(const v4u*)(Pu + (size_t)(t) * NIN), cc = *(const v4u*)(Pgc + (size_t)(t) * NIN); \
        dst[0] = bflo(uu.x) * bflo(cc.x); dst[1] = bfhi(uu.x) * bfhi(cc.x); dst[2] = bflo(uu.y) * bflo(cc.y); dst[3] = bfhi(uu.y) * bfhi(cc.y); \
        dst[4] = bflo(uu.z) * bflo(cc.z); dst[5] = bfhi(uu.z) * bfhi(cc.z); dst[6] = bflo(uu.w) * bflo(cc.w); dst[7] = bfhi(uu.w) * bfhi(cc.w); } \
        else { _Pragma("unroll") for (int k_ = 0; k_ < 8; ++k_) dst[k_] = 0.f; } } while (0)
    float hp[8], hc[8], hn[8];
    HROW(hp, t0 - 1); HROW(hc, t0);
    for (int t = t0; t < t0 + 32; ++t) {
        HROW(hn, t + 1);
        const v4u bb = *(const v4u*)(Pgb + (size_t)t * NIN);
        float gb[8] = {bflo(bb.x), bfhi(bb.x), bflo(bb.y), bfhi(bb.y), bflo(bb.z), bfhi(bb.z), bflo(bb.w), bfhi(bb.w)};
        float y[8]; float ssq = 0.f;
#pragma unroll
        for (int k = 0; k < 8; ++k) { y[k] = gb[k] * (w0[k] * hp[k] + w1[k] * hc[k] + w2[k] * hn[k]); ssq += y[k] * y[k]; }
        ssq = wave_sum(ssq);
        const float rstd = 1.0f / sqrtf(ssq * (1.0f / 512.0f) + LN_EPS);
        v4u o; o.x = pk2(y[0] * rstd * gc[0], y[1] * rstd * gc[1]); o.y = pk2(y[2] * rstd * gc[2], y[3] * rstd * gc[3]); o.z = pk2(y[4] * rstd * gc[4], y[5] * rstd * gc[5]); o.w = pk2(y[6] * rstd * gc[6], y[7] * rstd * gc[7]);
        *(v4u*)(MIX + (size_t)t * DM + 512 + ch0) = o;
#pragma unroll
        for (int k = 0; k < 8; ++k) { hp[k] = hc[k]; hc[k] = hn[k]; }
    }
#undef HROW
}

template <bool TO_BF16> __device__ __forceinline__ void ln_rows(const float* Y, float* OF, bf16* OB, const float* __restrict__ g, const float* __restrict__ bta, int gw, int ngw, int lane) {
    f32x4 gv[4], bv[4];
#pragma unroll
    for (int j = 0; j < 4; ++j) { gv[j] = *((const f32x4*)g + lane + 64 * j); bv[j] = *((const f32x4*)bta + lane + 64 * j); }
    for (int m = gw; m < MTOT; m += ngw) {
        const f32x4* xr = (const f32x4*)(Y + (size_t)m * DM) + lane;
        f32x4 v[4]; float s = 0.f;
#pragma unroll
        for (int j = 0; j < 4; ++j) { v[j] = xr[64 * j]; s += (v[j][0] + v[j][1]) + (v[j][2] + v[j][3]); }
        const float mean = wave_sum(s) * (1.f / DM); float s2 = 0.f;
#pragma unroll
        for (int j = 0; j < 4; ++j) { v[j] = v[j] - mean; s2 += (v[j][0] * v[j][0] + v[j][1] * v[j][1]) + (v[j][2] * v[j][2] + v[j][3] * v[j][3]); }
        const float rstd = 1.f / sqrtf(wave_sum(s2) * (1.f / DM) + LN_EPS);
#pragma unroll
        for (int j = 0; j < 4; ++j) { const f32x4 o = v[j] * rstd * gv[j] + bv[j];
            if (TO_BF16) { v2u w; w.x = pk2(o[0], o[1]); w.y = pk2(o[2], o[3]); *((v2u*)(OB + (size_t)m * DM) + lane + 64 * j) = w; }
            else *((f32x4*)(OF + (size_t)m * DM) + lane + 64 * j) = o; }
    }
}

#define XB_TMO      128
#define XB_XCNT(j)  (256  + 64 * (j))
#define XB_XSUB(j)  (1280 + 64 * (j))
#define XB_XGEN(j)  (2304 + 64 * (j))
#define XB_TOP      3328
#define XB_TOPGEN   3392
#define XCD_BAR_WORDS 3456
#define XB_SPIN_CAP (1u << 18)

__device__ __forceinline__ unsigned xb_ld(unsigned* p)              { return __hip_atomic_load(p, __ATOMIC_RELAXED, __HIP_MEMORY_SCOPE_AGENT); }
__device__ __forceinline__ unsigned xb_add(unsigned* p, unsigned v) { return __hip_atomic_fetch_add(p, v, __ATOMIC_RELAXED, __HIP_MEMORY_SCOPE_AGENT); }
__device__ __forceinline__ unsigned xb_xcc_id() { return (unsigned)__builtin_amdgcn_s_getreg((3 << 11) | 20) & 0xFu; }
#define XB_SPIN(cond, bar) do { unsigned _sp = 0; while (cond) { __builtin_amdgcn_s_sleep(1); \
    if ((++_sp & 255u) == 0u) { if (xb_ld(&(bar)[XB_TMO])) break; if (_sp > XB_SPIN_CAP) { atomicAdd(&(bar)[XB_TMO], 1u); break; } } } } while (0)

struct XcdBarrier {
    unsigned* bar; unsigned x;
    volatile LAS unsigned* st;
};

__device__ __forceinline__ XcdBarrier xcd_barrier_post(unsigned* bar, volatile LAS unsigned* st) {
    XcdBarrier b; b.bar = bar; b.x = xb_xcc_id(); b.st = st;
    if (threadIdx.x == 0) (void)xb_add(&bar[XB_XCNT(b.x)], 1u);
    return b;
}
__device__ __forceinline__ void xcd_barrier_complete(unsigned* bar, unsigned x, unsigned& nloc, unsigned& nx) {
    const unsigned G = gridDim.x * gridDim.y * gridDim.z;
    unsigned sum, cnt, mine, sp = 0u;
    for (;;) {
        sum = 0u; cnt = 0u; mine = 0u;
#pragma unroll
        for (unsigned j = 0; j < 16; ++j) { const unsigned c = xb_ld(&bar[XB_XCNT(j)]); sum += c; cnt += (c > 0u) ? 1u : 0u; mine = (j == x) ? c : mine; }
        if (sum == G) break;
        __builtin_amdgcn_s_sleep(1);
        if ((++sp & 255u) == 0u) { if (xb_ld(&bar[XB_TMO])) break; if (sp > XB_SPIN_CAP) { atomicAdd(&bar[XB_TMO], 1u); break; } }
    }
    nloc = mine > 0u ? mine : 1u; nx = cnt > 0u ? cnt : 1u;
}

__device__ __forceinline__ void xcd_barrier(const XcdBarrier& b) {
    asm volatile("s_waitcnt vmcnt(0)" ::: "memory");
    __syncthreads();
    if (threadIdx.x == 0) {
        unsigned* bar = b.bar;
        __builtin_amdgcn_s_waitcnt(0);
        unsigned nloc = b.st[0], nx = b.st[1];
        if (nloc == 0u) { xcd_barrier_complete(bar, b.x, nloc, nx); b.st[0] = nloc; b.st[1] = nx; }
        const unsigned old = xb_add(&bar[XB_XSUB(b.x)], 1u);
        const unsigned gen = old / nloc;
        if (old + 1u == (gen + 1u) * nloc) {
            __builtin_amdgcn_fence(__ATOMIC_RELEASE, "agent");
            asm volatile("s_waitcnt vmcnt(0)" ::: "memory");
            const unsigned og = xb_add(&bar[XB_TOP], 1u);
            const unsigned tg = og / nx;
            if (og + 1u == (tg + 1u) * nx) xb_add(&bar[XB_TOPGEN], 1u);
            else XB_SPIN(xb_ld(&bar[XB_TOPGEN]) == tg, bar);
            __builtin_amdgcn_fence(__ATOMIC_ACQUIRE, "agent");
            xb_add(&bar[XB_XGEN(b.x)], 1u);
            asm volatile("s_waitcnt vmcnt(0)" ::: "memory");
        } else {
            XB_SPIN(xb_ld(&bar[XB_XGEN(b.x)]) == gen, bar);
            __builtin_amdgcn_fence(__ATOMIC_ACQUIRE, "agent");
            asm volatile("s_waitcnt vmcnt(0)" ::: "memory");
        }
    }
    __syncthreads();
}

struct Args { const float* in[14]; float* out; unsigned char* ws; };
__global__ void __launch_bounds__(NWAVES * 64, 2) hymba_fwd(Args a) {
    extern __shared__ __attribute__((aligned(16))) unsigned char lds_raw[];
    cg::grid_group grid = cg::this_grid();
    LAS unsigned char* lds = (LAS unsigned char*)lds_raw;
    const int tid = threadIdx.x, lane = tid & 63, wave = __builtin_amdgcn_readfirstlane(tid >> 6);
    const int G = gridDim.x, bx = blockIdx.x;
    const int vcu = (G % 8 == 0) ? (bx % 8) * (G / 8) + bx / 8 : bx;
    const int gw = vcu * NWAVES + wave, NGW = G * NWAVES;
    const float *x_p = a.in[0], *x_s = a.in[1], *w_in = a.in[2], *conv_w = a.in[3], *g_attn = a.in[4], *g_conv = a.in[5], *w_o = a.in[6], *ln1_g = a.in[7], *ln1_b = a.in[8],
                *w_gate = a.in[9], *w_up = a.in[10], *w_down = a.in[11], *ln2_g = a.in[12], *ln2_b = a.in[13];
    unsigned char* ws = a.ws;
    bf16 *Win_t = (bf16*)(ws + WS_WIN), *Wo_t = (bf16*)(ws + WS_WO), *Wgu_t = (bf16*)(ws + WS_WGU), *Wd_t = (bf16*)(ws + WS_WD);
    bf16 *XB = (bf16*)a.out, *PART = (bf16*)a.out, *MIX = (bf16*)((unsigned char*)a.out + 128 * MiB), *Pb = (bf16*)(ws + WS_P), *X1B = (bf16*)(ws + WS_X1B), *HB = (bf16*)(ws + WS_H);
    float* Y1 = (float*)(ws + WS_Y1); float* LSE = (float*)(ws + WS_LSE);
    volatile LAS unsigned* MISC = (volatile LAS unsigned*)(lds + MISC_OFF);
    if (tid < 32) MISC[tid] = 0u;
    __syncthreads();
    const XcdBarrier bar = xcd_barrier_post((unsigned*)ws, MISC + 8);

    {
        LAS float* scr = (LAS float*)(lds + wave * 16384);
        constexpr int I_IN = (DM / 64) * (NIN / 32), I_O = (DM / 64) * (DM / 32), I_G = (DM / 64) * (FF / 32), I_D = (FF / 64) * (DM / 32);
        constexpr int NITEMS = I_IN + I_O + 2 * I_G + I_D;
        for (int it = gw; it < NITEMS; it += NGW) {
            int r = it;
            if (r < I_IN) { transpose_item(w_in, DM, NIN, Win_t, 0, scr, r, lane); continue; } r -= I_IN;
            if (r < I_O) { transpose_item(w_o, DM, DM, Wo_t, 0, scr, r, lane); continue; } r -= I_O;
            if (r < I_G) { transpose_item(w_gate, DM, FF, Wgu_t, 1, scr, r, lane); continue; } r -= I_G;
            if (r < I_G) { transpose_item(w_up, DM, FF, Wgu_t, 2, scr, r, lane); continue; } r -= I_G;
            transpose_item(w_down, FF, DM, Wd_t, 0, scr, r, lane);
        }
        const int gt = vcu * (NWAVES * 64) + tid, ngt = G * NWAVES * 64;
        constexpr int NGRP = MTOT * DM / 8, NGRP_P = MP * DM / 8;
        for (int q = gt; q < NGRP; q += ngt) {
            const float* src = q < NGRP_P ? x_p + (size_t)q * 8 : x_s + (size_t)(q - NGRP_P) * 8;
            const f32x4 v0 = *(const f32x4*)src, v1 = *(const f32x4*)(src + 4);
            v4u o; o.x = pk2(v0[0], v0[1]); o.y = pk2(v0[2], v0[3]); o.z = pk2(v1[0], v1[1]); o.w = pk2(v1[2], v1[3]);
            *(v4u*)(XB + (size_t)q * 8) = o;
        }
    }
    grid.sync();
    {
        pg8::Gemm g{XB, Win_t, MTOT, NIN, DM}; pg8::StaticOrder S; S.init(MTOT, NIN, G, bx);
        pg8::EpiStoreBf16 E{Pb, NIN};
        pg8::gemm_phase<pg8::EpiStoreBf16, pg8::StaticOrder, true, true>(lds, g, S, E);
    }
    xcd_barrier(bar);
    {
        attn_pass<0>(Pb, PART, LSE, MIX, g_attn, lds, vcu, wave, lane);
        for (int t = gw; t < MTOT / 32; t += NGW) conv_rows(Pb, MIX, conv_w, g_conv, t * 32, lane);
        xcd_barrier(bar);
        attn_pass<1>(Pb, PART, LSE, MIX, g_attn, lds, vcu, wave, lane);
    }
    xcd_barrier(bar);
    {
        pg8::Gemm g{MIX, Wo_t, MTOT, DM, DM}; pg8::StaticOrder S; S.init(MTOT, DM, G, bx);
        pg8::EpiRes<false> E{x_p, x_s, MP, Y1, ALPHA};
        pg8::gemm_phase<pg8::EpiRes<false>, pg8::StaticOrder, true, true>(lds, g, S, E);
    }
    xcd_barrier(bar);
    ln_rows<true>(Y1, nullptr, X1B, ln1_g, ln1_b, gw, NGW, lane);
    xcd_barrier(bar);
    {
        pg8::Gemm g{X1B, Wgu_t, MTOT, NGU, DM}; pg8::StaticOrder S; S.init(MTOT, NGU, G, bx);
        pg8::EpiSwiglu E{HB, FF};
        pg8::gemm_phase<pg8::EpiSwiglu, pg8::StaticOrder, true, true>(lds, g, S, E);
    }
    xcd_barrier(bar);
    {
        pg8::Gemm g{HB, Wd_t, MTOT, DM, FF}; pg8::StaticOrder S; S.init(MTOT, DM, G, bx);
        pg8::EpiRes<true> E{X1B, nullptr, MTOT, a.out, ALPHA};
        pg8::gemm_phase<pg8::EpiRes<true>, pg8::StaticOrder, true, true>(lds, g, S, E);
    }
    xcd_barrier(bar);
    ln_rows<false>(a.out, a.out, nullptr, ln2_g, ln2_b, gw, NGW, lane);
}

extern "C" void kernel_launch(void* const* d_in, const int* in_sizes, int n_in, void* d_out, int out_size, void* d_ws, size_t ws_size, hipStream_t stream) {
    static int grid = 0;
    if (grid == 0) {
        if (n_in != 14 || out_size != MTOT * DM || ws_size < WS_END) { fprintf(stderr, "kernel_launch: unexpected shapes (n_in %d, out %d, ws %zu); nothing launched\n", n_in, out_size, ws_size); grid = -1; return; }
        int dev = 0, cus = 0, per_cu = 0;
        if (hipGetDevice(&dev) != hipSuccess || hipDeviceGetAttribute(&cus, hipDeviceAttributeMultiprocessorCount, dev) != hipSuccess) { grid = -1; return; }
        if (hipFuncSetAttribute((const void*)hymba_fwd, hipFuncAttributeMaxDynamicSharedMemorySize, LDS_BYTES) != hipSuccess) { fprintf(stderr, "kernel_launch: hipFuncSetAttribute failed\n"); grid = -1; return; }
        if (hipOccupancyMaxActiveBlocksPerMultiprocessor(&per_cu, (const void*)hymba_fwd, NWAVES * 64, LDS_BYTES) != hipSuccess || per_cu < 1) { fprintf(stderr, "kernel_launch: occupancy query says %d\n", per_cu); per_cu = 1; }
        (void)hipGetLastError();
        grid = cus * 1;
    }
    if (grid < 0) return;
    Args a{};
    for (int i = 0; i < 14; ++i) a.in[i] = (const float*)d_in[i];
    a.out = (float*)d_out; a.ws = (unsigned char*)d_ws;
    if (hipMemsetAsync(d_ws, 0, CTL_ZERO_BYTES, stream) != hipSuccess) { fprintf(stderr, "kernel_launch: memset of the barrier words failed\n"); return; }
    void* args[] = {&a};
    hipError_t e = hipLaunchCooperativeKernel((const void*)hymba_fwd, dim3(grid), dim3(NWAVES * 64), args, LDS_BYTES, stream);
    if (e != hipSuccess) fprintf(stderr, "kernel_launch: cooperative launch failed: %s (grid %d)\n", hipGetErrorString(e), grid);
}
```
